# Optimizing an MI355X kernel written in HIP

```python
import numpy as np
import jax, jax.numpy as jnp
from jax import lax

D_MODEL = 2048
BATCH = 8
SEQ = 2048
DEPTH = 2

D_CONV = D_MODEL // 4
CONV_WIDTH = 31
D_RNN = 3 * D_MODEL // 8
RNN_BLOCKS = 6
RNN_BLOCK_W = D_RNN // RNN_BLOCKS
RNN_CONV_WIDTH = 4
RG_C = 8.0
N_Q_HEADS = 6
N_KV_HEADS = 2
HEAD_DIM = 128
GROUP = N_Q_HEADS // N_KV_HEADS
D_ATTN = N_Q_HEADS * HEAD_DIM
KV_W = N_KV_HEADS * HEAD_DIM
CMP_BLOCK = 32
CMP_STRIDE = 16
SEL_BLOCK = 64
SEL_TOP_N = 16
WINDOW = 512
Q_BLOCK = 64
ROPE_THETA = 10000.0
D_FF = 4 * D_MODEL
NORM_EPS = 1e-6
NEG_INF = -1e30
POS_INF = 1e30

IN_SIZES = (D_CONV, D_CONV,
            D_RNN, D_RNN,
            D_ATTN,
            KV_W, KV_W, KV_W, KV_W, KV_W, KV_W,
            3 * N_Q_HEADS,
            D_MODEL, D_MODEL, D_MODEL)
N_IN = sum(IN_SIZES)

kernel_name = 'hybrid_conv_rglru_nsa_block'


def rms_norm(x, g):
    xf = x.astype(jnp.float32)
    y = xf * lax.rsqrt(jnp.mean(xf * xf, axis=-1, keepdims=True) + NORM_EPS)
    return (y * g).astype(x.dtype)


def layer_norm(x, g, b):
    xf = x.astype(jnp.float32)
    mu = jnp.mean(xf, axis=-1, keepdims=True)
    var = jnp.mean(jnp.square(xf - mu), axis=-1, keepdims=True)
    return ((xf - mu) * lax.rsqrt(var + NORM_EPS) * g + b).astype(x.dtype)


def masked_softmax(s, mask):
    p = jax.nn.softmax(jnp.where(mask, s, NEG_INF), axis=-1)
    return jnp.where(mask, p, 0.0)


def causal_depthwise_conv(x, w, b):
    k, c = w.shape
    y = lax.conv_general_dilated(x, w[:, None, :].astype(x.dtype), window_strides=(1,),
                                 padding=[(k - 1, 0)], dimension_numbers=('NWC', 'WIO', 'NWC'),
                                 feature_group_count=c)
    return y + b


def rope_tables(s):
    inv = 1.0 / (ROPE_THETA ** (jnp.arange(0, HEAD_DIM, 2, dtype=jnp.float32) / HEAD_DIM))
    ang = jnp.arange(s, dtype=jnp.float32)[:, None] * inv[None, :]
    return jnp.cos(ang)[:, None, :], jnp.sin(ang)[:, None, :]


def apply_rope(x, cos, sin):
    xf = x.astype(jnp.float32)
    x1, x2 = jnp.split(xf, 2, axis=-1)
    return jnp.concatenate([x1 * cos - x2 * sin, x2 * cos + x1 * sin], axis=-1).astype(x.dtype)


def _lin_combine(left, right):
    a1, b1 = left
    a2, b2 = right
    return a1 * a2, a2 * b1 + b2


def rg_lru(x, wa, ba, wx, bx, lam):
    b, s, d = x.shape
    xb = x.reshape(b, s, RNN_BLOCKS, RNN_BLOCK_W)
    r = jax.nn.sigmoid((jnp.einsum('bsnc,ncd->bsnd', xb, wa).reshape(b, s, d) + ba).astype(jnp.float32))
    i = jax.nn.sigmoid((jnp.einsum('bsnc,ncd->bsnd', xb, wx).reshape(b, s, d) + bx).astype(jnp.float32))
    log_a = -RG_C * jax.nn.softplus(-lam.astype(jnp.float32)) * r
    a = jnp.exp(log_a)
    gated_x = jnp.sqrt(-jnp.expm1(2.0 * log_a)) * (i * x.astype(jnp.float32))
    _, h = lax.associative_scan(_lin_combine, (a, gated_x), axis=1)
    return h.astype(x.dtype)


def nsa_attention(q, k_cmp, v_cmp, k_slc, v_slc, k_win, v_win, gates, cos, sin,
                  cmp_pe, cmp_k_w1, cmp_k_w2, cmp_v_w1, cmp_v_w2):
    b, s = q.shape[:2]
    scale = HEAD_DIM ** -0.5
    q_rot = apply_rope(q, cos, sin)
    k_slc = apply_rope(k_slc, cos, sin)
    k_win = apply_rope(k_win, cos, sin)

    n_cmp = (s - CMP_BLOCK) // CMP_STRIDE + 1
    cmp_idx = np.arange(n_cmp)[:, None] * CMP_STRIDE + np.arange(CMP_BLOCK)[None, :]

    def compress(kv, w1, w2):
        blk = kv[:, cmp_idx] + cmp_pe[None, None, :, None, :]
        blk = blk.transpose(0, 1, 3, 2, 4).reshape(b, n_cmp, N_KV_HEADS, CMP_BLOCK * HEAD_DIM)
        return jax.nn.gelu(blk @ w1) @ w2

    kc = compress(k_cmp, cmp_k_w1, cmp_k_w2)
    vc = compress(v_cmp, cmp_v_w1, cmp_v_w2)
    cmp_end = jnp.asarray(cmp_idx[:, -1], dtype=jnp.int32)

    n_sel = s // SEL_BLOCK
    n_top = min(SEL_TOP_N, n_sel)
    c_start = np.arange(n_cmp) * CMP_STRIDE
    s_start = np.arange(n_sel) * SEL_BLOCK
    overlap = jnp.asarray(((c_start[:, None] < s_start[None, :] + SEL_BLOCK)
                           & (c_start[:, None] + CMP_BLOCK > s_start[None, :])).astype(np.float32))
    ksb = k_slc.reshape(b, n_sel, SEL_BLOCK, N_KV_HEADS, HEAD_DIM).transpose(0, 3, 1, 2, 4)
    vsb = v_slc.reshape(b, n_sel, SEL_BLOCK, N_KV_HEADS, HEAD_DIM).transpose(0, 3, 1, 2, 4)
    gather = jax.vmap(jax.vmap(lambda blocks, idx: blocks[idx]))

    kw_pad = jnp.pad(k_win, ((0, 0), (WINDOW, 0), (0, 0), (0, 0)))
    vw_pad = jnp.pad(v_win, ((0, 0), (WINDOW, 0), (0, 0), (0, 0)))

    nq = s // Q_BLOCK

    def to_blocks(a):
        a = a.reshape(b, nq, Q_BLOCK, N_KV_HEADS, GROUP, a.shape[-1])
        return jnp.moveaxis(a, 1, 0)

    def block_fn(args):
        c, qn, qr, g = args
        t = c * Q_BLOCK + jnp.arange(Q_BLOCK, dtype=jnp.int32)
        s_c = jnp.einsum('bqhgd,bnhd->bhgqn', qn, kc).astype(jnp.float32) * scale
        p_c = masked_softmax(s_c, cmp_end[None, :] <= t[:, None])
        o_c = jnp.einsum('bhgqn,bnhd->bqhgd', p_c.astype(vc.dtype), vc)
        imp = jnp.einsum('bhgqn,nm->bhqm', p_c, overlap)
        blk = jnp.arange(n_sel, dtype=jnp.int32)[None, :]
        cur = (t // SEL_BLOCK)[:, None]
        valid = blk * SEL_BLOCK <= t[:, None]
        forced = (blk == 0) | (blk == cur) | (blk == cur - 1)
        score = jnp.where(valid, jnp.where(forced, POS_INF, imp), NEG_INF)
        _, idx = lax.top_k(score, n_top)
        kg = gather(ksb, idx)
        vg = gather(vsb, idx)
        kpos = idx[..., None] * SEL_BLOCK + jnp.arange(SEL_BLOCK, dtype=jnp.int32)
        m_s = (kpos <= t[:, None, None]).reshape(b, N_KV_HEADS, 1, Q_BLOCK, n_top * SEL_BLOCK)
        s_s = jnp.einsum('bqhgd,bhqnkd->bhgqnk', qr, kg).astype(jnp.float32) * scale
        p_s = masked_softmax(s_s.reshape(b, N_KV_HEADS, GROUP, Q_BLOCK, n_top * SEL_BLOCK), m_s)
        o_s = jnp.einsum('bhgqm,bhqmd->bqhgd', p_s.astype(vg.dtype),
                         vg.reshape(b, N_KV_HEADS, Q_BLOCK, n_top * SEL_BLOCK, HEAD_DIM))
        kw = lax.dynamic_slice_in_dim(kw_pad, c * Q_BLOCK, WINDOW + Q_BLOCK, axis=1)
        vw = lax.dynamic_slice_in_dim(vw_pad, c * Q_BLOCK, WINDOW + Q_BLOCK, axis=1)
        kpos_w = c * Q_BLOCK - WINDOW + jnp.arange(WINDOW + Q_BLOCK, dtype=jnp.int32)
        diff = t[:, None] - kpos_w[None, :]
        m_w = (diff >= 0) & (diff < WINDOW) & (kpos_w[None, :] >= 0)
        s_w = jnp.einsum('bqhgd,bkhd->bhgqk', qr, kw).astype(jnp.float32) * scale
        p_w = masked_softmax(s_w, m_w)
        o_w = jnp.einsum('bhgqk,bkhd->bqhgd', p_w.astype(vw.dtype), vw)
        return g[..., 0:1] * o_c + g[..., 1:2] * o_s + g[..., 2:3] * o_w

    o = lax.map(block_fn, (jnp.arange(nq, dtype=jnp.int32), to_blocks(q), to_blocks(q_rot), to_blocks(gates)))
    return jnp.moveaxis(o, 0, 1).reshape(b, s, D_ATTN)


def setup_inputs(seed: int = 0) -> dict:
    key = jax.random.key(seed)
    ks = jax.random.split(key, 32)
    L = DEPTH
    f32 = jnp.float32

    def nrm(k, shape, fan_in):
        return jax.random.normal(k, shape, f32) * (fan_in ** -0.5)

    def gain(k, shape):
        return 1.0 + 0.02 * jax.random.normal(k, shape, f32)

    def bias(k, shape):
        return 0.02 * jax.random.normal(k, shape, f32)

    u = jax.random.uniform(ks[14], (L, D_RNN), f32, minval=0.9, maxval=0.999)
    sa = u ** (1.0 / RG_C)
    return {
        'x': jax.random.normal(ks[0], (BATCH, SEQ, D_MODEL), f32),
        'attn_norm_g': gain(ks[1], (L, D_MODEL)),
        'w_in': nrm(ks[2], (L, D_MODEL, N_IN), D_MODEL),
        'conv_dw_w': nrm(ks[3], (L, CONV_WIDTH, D_CONV), CONV_WIDTH),
        'conv_dw_b': bias(ks[4], (L, D_CONV)),
        'conv_ln_g': gain(ks[5], (L, D_CONV)),
        'conv_ln_b': bias(ks[6], (L, D_CONV)),
        'w_conv_out': nrm(ks[7], (L, D_CONV, D_MODEL), D_CONV),
        'rnn_conv_w': nrm(ks[8], (L, RNN_CONV_WIDTH, D_RNN), RNN_CONV_WIDTH),
        'rnn_conv_b': bias(ks[9], (L, D_RNN)),
        'rglru_wa': nrm(ks[10], (L, RNN_BLOCKS, RNN_BLOCK_W, RNN_BLOCK_W), RNN_BLOCK_W),
        'rglru_ba': bias(ks[11], (L, D_RNN)),
        'rglru_wx': nrm(ks[12], (L, RNN_BLOCKS, RNN_BLOCK_W, RNN_BLOCK_W), RNN_BLOCK_W),
        'rglru_bx': bias(ks[13], (L, D_RNN)),
        'rglru_lambda': jnp.log(sa) - jnp.log1p(-sa),
        'w_rnn_out': nrm(ks[15], (L, D_RNN, D_MODEL), D_RNN),
        'cmp_pe': 0.02 * jax.random.normal(ks[16], (L, CMP_BLOCK, HEAD_DIM), f32),
        'cmp_k_w1': nrm(ks[17], (L, CMP_BLOCK * HEAD_DIM, HEAD_DIM), CMP_BLOCK * HEAD_DIM),
        'cmp_k_w2': nrm(ks[18], (L, HEAD_DIM, HEAD_DIM), HEAD_DIM),
        'cmp_v_w1': nrm(ks[19], (L, CMP_BLOCK * HEAD_DIM, HEAD_DIM), CMP_BLOCK * HEAD_DIM),
        'cmp_v_w2': nrm(ks[20], (L, HEAD_DIM, HEAD_DIM), HEAD_DIM),
        'w_attn_out': nrm(ks[21], (L, D_ATTN, D_MODEL), D_ATTN),
        'w_o': nrm(ks[22], (L, D_MODEL, D_MODEL), D_MODEL),
        'mlp_norm_g': gain(ks[23], (L, D_MODEL)),
        'w_mlp_up': nrm(ks[24], (L, D_MODEL, D_FF), D_MODEL),
        'w_mlp_down': nrm(ks[25], (L, D_FF, D_MODEL), D_FF),
        'final_norm_g': gain(ks[26], (D_MODEL,)),
    }


def reference(x, attn_norm_g, w_in, conv_dw_w, conv_dw_b, conv_ln_g, conv_ln_b, w_conv_out,
              rnn_conv_w, rnn_conv_b, rglru_wa, rglru_ba, rglru_wx, rglru_bx, rglru_lambda, w_rnn_out,
              cmp_pe, cmp_k_w1, cmp_k_w2, cmp_v_w1, cmp_v_w2, w_attn_out,
              w_o, mlp_norm_g, w_mlp_up, w_mlp_down, final_norm_g):
    b, s, _ = x.shape
    cos, sin = rope_tables(s)
    split_points = [int(v) for v in np.cumsum(IN_SIZES)[:-1]]

    def kv_heads(z):
        return z.reshape(b, s, N_KV_HEADS, HEAD_DIM)

    for l in range(DEPTH):
        h = rms_norm(x, attn_norm_g[l])
        proj = h @ w_in[l]
        (a_val, a_gate, r_x, r_gate, c_q, c_kc, c_vc, c_ks, c_vs, c_kw, c_vw, c_g,
         g_a, g_b, g_c) = jnp.split(proj, split_points, axis=-1)

        u = a_val * jax.nn.sigmoid(a_gate)
        u = causal_depthwise_conv(u, conv_dw_w[l], conv_dw_b[l])
        u = jax.nn.silu(layer_norm(u, conv_ln_g[l], conv_ln_b[l]))
        p_a = u @ w_conv_out[l]

        r = causal_depthwise_conv(r_x, rnn_conv_w[l], rnn_conv_b[l])
        r = rg_lru(r, rglru_wa[l], rglru_ba[l], rglru_wx[l], rglru_bx[l], rglru_lambda[l])
        p_b = (r * jax.nn.gelu(r_gate)) @ w_rnn_out[l]

        o = nsa_attention(c_q.reshape(b, s, N_Q_HEADS, HEAD_DIM), kv_heads(c_kc), kv_heads(c_vc),
                          kv_heads(c_ks), kv_heads(c_vs), kv_heads(c_kw), kv_heads(c_vw),
                          jax.nn.sigmoid(c_g).reshape(b, s, N_Q_HEADS, 3), cos, sin,
                          cmp_pe[l], cmp_k_w1[l], cmp_k_w2[l], cmp_v_w1[l], cmp_v_w2[l])
        p_c = o @ w_attn_out[l]

        y = jax.nn.sigmoid(g_a) * p_a + jax.nn.sigmoid(g_b) * p_b + jax.nn.sigmoid(g_c) * p_c
        x = x + y @ w_o[l]

        h2 = rms_norm(x, mlp_norm_g[l])
        x = x + jnp.square(jax.nn.relu(h2 @ w_mlp_up[l])) @ w_mlp_down[l]

    return rms_norm(x, final_norm_g)
```

```cpp
#include <hip/hip_runtime.h>
#include <hip/hip_cooperative_groups.h>
#include <cstdio>
#include <cstdint>

namespace cg = cooperative_groups;

#define LAS __attribute__((address_space(3)))
typedef unsigned short bf16_t;
typedef short bf16x8 __attribute__((ext_vector_type(8)));
typedef float f32x4 __attribute__((ext_vector_type(4)));
typedef float f32x2 __attribute__((ext_vector_type(2)));
typedef unsigned u32x4 __attribute__((ext_vector_type(4)));
typedef unsigned u32x2 __attribute__((ext_vector_type(2)));
typedef short tr4_t __attribute__((ext_vector_type(4)));

constexpr int T_ = 16384, DM = 2048, SEQ = 2048, NBATCH = 8, NLAYER = 2;
constexpr int NIN = 11026, NINP = 11264;
constexpr int DCONV = 512, DRNN = 768, DATT = 768, DFF = 8192;
constexpr int KVROWS = T_ + 64;
constexpr float C2 = 0.08838834764831845f * 1.4426950408889634f;
constexpr float NORM_EPS = 1e-6f;

constexpr size_t MiB = 1u << 20;
constexpr size_t WS_CTL = 0, WS_ROPE = 1 * MiB, WS_WIN = 2 * MiB, WS_WCO = 46 * MiB, WS_WRO = 48 * MiB, WS_WAO = 51 * MiB, WS_WO = 54 * MiB,
                 WS_WUP = 62 * MiB, WS_WDN = 94 * MiB, WS_WG = 126 * MiB, WS_W1K = 127 * MiB, WS_W1V = 129 * MiB,
                 WS_ACT = 131 * MiB, WS_H = 195 * MiB, WS_R1 = 259 * MiB, WS_XC = 307 * MiB, WS_GG = 331 * MiB, WS_Q = 355 * MiB, WS_QR = 379 * MiB,
                 WS_KCMP = 403 * MiB, WS_VCMP = 412 * MiB, WS_KSLC = 421 * MiB, WS_VSLC = 429 * MiB, WS_KWIN = 437 * MiB, WS_VWIN = 445 * MiB,
                 WS_CG = 453 * MiB, WS_GATES = 455 * MiB, WS_PART = 647 * MiB, WS_KC = 663 * MiB, WS_VC = 664 * MiB, WS_SEL = 665 * MiB, WS_U = 666 * MiB, WS_END = 682 * MiB;
constexpr size_t CTL_BPART = 65536, CTL_SPC = 131072, CTL_BAR = 262144, CTL_BAR_BYTES = 16384, CTL_RSS = 524288, CTL_ZERO_BYTES = 524288;

constexpr int LDS_BYTES = 147456;

__device__ __forceinline__ unsigned f2bf(float f) { unsigned u = __builtin_bit_cast(unsigned, f); return (u + 0x7fffu + ((u >> 16) & 1u)) >> 16; }
typedef __bf16 hwbf16x2 __attribute__((ext_vector_type(2)));
__device__ __forceinline__ unsigned pk2(float lo, float hi) { const f32x2 v = {lo, hi}; const hwbf16x2 b = __builtin_convertvector(v, hwbf16x2); return __builtin_bit_cast(unsigned, b); }
__device__ __forceinline__ float bf2f(unsigned b) { return __builtin_bit_cast(float, b << 16); }
__device__ __forceinline__ float bflo(unsigned w) { return __builtin_bit_cast(float, w << 16); }
__device__ __forceinline__ float bfhi(unsigned w) { return __builtin_bit_cast(float, w & 0xffff0000u); }
__device__ __forceinline__ float sigmoidf_(float x) { return __builtin_amdgcn_rcpf(1.0f + __expf(-x)); }
__device__ __forceinline__ float gelu_tanh(float x) { const float y = 1.5957691216057308f * (x + 0.044715f * x * x * x); return x * sigmoidf_(y); }
__device__ __forceinline__ float shx(float v, int mask, int lane) { return __builtin_bit_cast(float, __builtin_amdgcn_ds_bpermute((lane ^ mask) << 2, __builtin_bit_cast(int, v))); }
__device__ __forceinline__ unsigned shx(unsigned v, int mask, int lane) { return (unsigned)__builtin_amdgcn_ds_bpermute((lane ^ mask) << 2, (int)v); }
__device__ __forceinline__ float shidx(float v, int src) { return __builtin_bit_cast(float, __builtin_amdgcn_ds_bpermute(src << 2, __builtin_bit_cast(int, v))); }
__device__ __forceinline__ float wave_sum(float v, int lane) {
#pragma unroll
    for (int o = 1; o < 64; o <<= 1) v += shx(v, o, lane);
    return v;
}
__device__ __forceinline__ float wave_max(float v, int lane) {
#pragma unroll
    for (int o = 1; o < 64; o <<= 1) v = fmaxf(v, shx(v, o, lane));
    return v;
}
__device__ __forceinline__ float wave_sum_OLD(float v) {
#pragma unroll
    for (int o = 1; o < 64; o <<= 1) v += __shfl_xor(v, o);
    return v;
}
__device__ __forceinline__ float wave_max(float v) {
#pragma unroll
    for (int o = 1; o < 64; o <<= 1) v = fmaxf(v, __shfl_xor(v, o));
    return v;
}
#define LDS_WAIT() asm volatile("s_waitcnt lgkmcnt(0)" ::: "memory")

namespace pg8 {
constexpr int BM = 256, BK = 64, HALF = 128, HTB = HALF * BK * 2, STAGE_BYTES = 8 * HTB, NXCD = 8, WGM = 8;
__device__ __forceinline__ int lds_byte(int r, int c) { const int st = (r >> 4) * 2 + (c >> 5), rr = r & 15, cc = c & 31, ob = rr * 64 + cc * 2; return st * 1024 + (ob ^ (((ob >> 9) & 1) << 5)); }
__device__ __forceinline__ void stage_rc(int b, int& R, int& C) { const int st = b / 1024, sb = b % 1024, swz = sb ^ (((sb >> 9) & 1) << 5); R = (st >> 1) * 16 + swz / 64; C = (st & 1) * 32 + (swz % 64) / 2; }
__device__ __forceinline__ int perm32(int rho) { const int n = rho >> 4, i = rho & 15; return 8 * (i >> 2) + 4 * n + (i & 3); }

struct Unit { int pm, pn; const char* a; const char* b; };

struct StdSched {
    const char* A; const char* B; size_t a_tile, b_tile; int nM, nN, nwg, G, c;
    __device__ void init(const void* A_, int lda, const void* B_, int ldb, int M, int N, int G_, int c_) {
        A = (const char*)A_; B = (const char*)B_; a_tile = (size_t)BM * lda * 2; b_tile = (size_t)BM * ldb * 2; nM = M / BM; nN = N / BM; nwg = nM * nN; G = G_; c = c_; }
    __device__ bool next(int i, Unit& u) const {
        const long L = (long)i * G + c; if (L >= nwg) return false;
        int wgid = (int)L; { const int q = nwg / NXCD, r = nwg % NXCD, xcd = wgid % NXCD, off = wgid / NXCD; wgid = (xcd < r ? xcd * (q + 1) : r * (q + 1) + (xcd - r) * q) + off; }
        const int nig = WGM * nN, gid = wgid / nig, fm = gid * WGM, gsz = (nM - fm) < WGM ? (nM - fm) : WGM;
        u.pm = fm + ((wgid % nig) % gsz); u.pn = (wgid % nig) / gsz; u.a = A + (size_t)u.pm * a_tile; u.b = B + (size_t)u.pn * b_tile; return true;
    }
};

template <class Epi, class Sched>
__device__ __forceinline__ void gemm_phase(LAS unsigned char* lds, const int tid, const int K, const int lda, const int ldb, const Sched& S, const Epi& E) {
    const int wid = __builtin_amdgcn_readfirstlane(tid >> 6), lane = tid & 63, wr = wid >> 2, wc = wid & 3, fr = lane & 15, fq = lane >> 4;
    const int nt = K / BK;
    unsigned voffA[2], voffB[2];
#pragma unroll
    for (int i = 0; i < 2; ++i) { int R, C; stage_rc(tid * 16 + i * 8192, R, C); const int Rb = Epi::PERM ? ((R & ~31) + perm32(R & 31)) : R;
        voffA[i] = (unsigned)(R * lda + C) * 2u; voffB[i] = (unsigned)(Rb * ldb + C) * 2u; }
    const size_t kstep = (size_t)(BK * 2);
    const size_t hstepA = (size_t)HALF * lda * 2, hstepB = (size_t)HALF * ldb * 2;
    const unsigned ldsw = (unsigned)wid * 1024u;
    const int aoff = lds_byte(wr * 64 + fr, fq * 8), boff = lds_byte(wc * 32 + fr, fq * 8);
#define PG8_SA(b, h) (((b) * 2 + (h)) * HTB)
#define PG8_SB(b, h) ((4 + (b) * 2 + (h)) * HTB)
#define PG8_STAGE(bufoff, gbase, voff) do { _Pragma("unroll") for (int _i = 0; _i < 2; ++_i) \
        __builtin_amdgcn_global_load_lds((const unsigned*)((const char*)(gbase) + (voff)[_i]), (LAS unsigned*)(lds + (bufoff) + ldsw + _i * 8192), 16, 0, 0); } while (0)
#define PG8_LDA(dst, b, h) do { _Pragma("unroll") for (int m = 0; m < 4; ++m) _Pragma("unroll") for (int k = 0; k < 2; ++k) dst[m][k] = *(const LAS bf16x8*)(lds + PG8_SA(b, h) + aoff + m * 2048 + k * 1024); } while (0)
#define PG8_LDB(dst, b, h) do { _Pragma("unroll") for (int n = 0; n < 2; ++n) _Pragma("unroll") for (int k = 0; k < 2; ++k) dst[n][k] = *(const LAS bf16x8*)(lds + PG8_SB(b, h) + boff + n * 2048 + k * 1024); } while (0)
#define PG8_MMA(ai, bj, At, Bt) do { __builtin_amdgcn_s_setprio(1); _Pragma("unroll") for (int m = 0; m < 4; ++m) _Pragma("unroll") for (int n = 0; n < 2; ++n) _Pragma("unroll") for (int k = 0; k < 2; ++k) \
        acc[ai][bj][m][n] = __builtin_amdgcn_mfma_f32_16x16x32_bf16(Bt[n][k], At[m][k], acc[ai][bj][m][n], 0, 0, 0); __builtin_amdgcn_s_setprio(0); } while (0)
#define PG8_WAIT_V(n) asm volatile("s_waitcnt vmcnt(" #n ")" ::: "memory")
#define PG8_WAIT_L(n) asm volatile("s_waitcnt lgkmcnt(" #n ")" ::: "memory")
#define PG8_BAR __builtin_amdgcn_s_barrier()
#define PG8_SCHED __builtin_amdgcn_sched_barrier(0)
    Unit cur, nxt; int ui = 0;
    if (!S.next(0, cur)) return;
    f32x4 acc[2][2][4][2];
#pragma unroll
    for (int a = 0; a < 2; ++a)
#pragma unroll
        for (int b = 0; b < 2; ++b)
#pragma unroll
            for (int m = 0; m < 4; ++m)
#pragma unroll
                for (int n = 0; n < 2; ++n) acc[a][b][m][n] = (f32x4){0.f, 0.f, 0.f, 0.f};
    bf16x8 At[4][2], B0[2][2], B1[2][2];
    const char* cA = cur.a; const char* cB = cur.b;
    PG8_STAGE(PG8_SB(0, 0), cB, voffB); PG8_STAGE(PG8_SB(0, 1), cB + hstepB, voffB); PG8_STAGE(PG8_SA(0, 0), cA, voffA); PG8_STAGE(PG8_SA(0, 1), cA + hstepA, voffA);
    if (wr == 1) PG8_BAR;
    PG8_WAIT_V(2); PG8_BAR;
    PG8_STAGE(PG8_SB(1, 0), cB + kstep, voffB); PG8_STAGE(PG8_SA(1, 0), cA + kstep, voffA); PG8_STAGE(PG8_SB(1, 1), cB + hstepB + kstep, voffB);
    PG8_WAIT_V(6); PG8_BAR;
    for (;;) {
        const bool has_next = S.next(ui + 1, nxt);
        const char* nA = has_next ? nxt.a : cA; const char* nB = has_next ? nxt.b : cB;
        for (int t = 0; t < nt; t += 2) {
            const bool last = (t == nt - 2);
            const char* a1 = cA + (size_t)(t + 1) * kstep;
            const char* a2 = last ? nA : cA + (size_t)(t + 2) * kstep; const char* b2 = last ? nB : cB + (size_t)(t + 2) * kstep;
            const char* a3 = a2 + kstep; const char* b3 = b2 + kstep;
            PG8_LDB(B0, 0, 0); PG8_LDB(B1, 0, 1); PG8_SCHED; PG8_LDA(At, 0, 0); PG8_STAGE(PG8_SA(1, 1), a1 + hstepA, voffA);
            PG8_WAIT_V(8); PG8_WAIT_L(0); PG8_BAR; PG8_MMA(0, 0, At, B0); PG8_MMA(0, 1, At, B1); PG8_BAR; PG8_SCHED;
            PG8_LDA(At, 0, 1); PG8_STAGE(PG8_SB(0, 0), b2, voffB); PG8_STAGE(PG8_SB(0, 1), b2 + hstepB, voffB); PG8_STAGE(PG8_SA(0, 0), a2, voffA);
            PG8_WAIT_V(8); PG8_WAIT_L(0); PG8_BAR; PG8_MMA(1, 0, At, B0); PG8_MMA(1, 1, At, B1); PG8_BAR; PG8_SCHED;
            PG8_LDB(B0, 1, 0); PG8_LDB(B1, 1, 1); PG8_SCHED; PG8_LDA(At, 1, 0); PG8_STAGE(PG8_SA(0, 1), a2 + hstepA, voffA);
            PG8_WAIT_V(8); PG8_WAIT_L(0); PG8_BAR; PG8_MMA(0, 0, At, B0); PG8_MMA(0, 1, At, B1); PG8_BAR; PG8_SCHED;
            PG8_LDA(At, 1, 1); PG8_STAGE(PG8_SB(1, 0), b3, voffB); PG8_STAGE(PG8_SB(1, 1), b3 + hstepB, voffB); PG8_STAGE(PG8_SA(1, 0), a3, voffA);
            PG8_WAIT_V(8); PG8_WAIT_L(0); PG8_BAR; PG8_MMA(1, 0, At, B0); PG8_MMA(1, 1, At, B1); PG8_BAR; PG8_SCHED;
        }
        if (wr == 0) PG8_BAR;
        E(acc, cur, wr, wc, fr, fq);
        if (!has_next) break;
#pragma unroll
        for (int a = 0; a < 2; ++a)
#pragma unroll
            for (int b = 0; b < 2; ++b)
#pragma unroll
                for (int m = 0; m < 4; ++m)
#pragma unroll
                    for (int n = 0; n < 2; ++n) acc[a][b][m][n] = (f32x4){0.f, 0.f, 0.f, 0.f};
        cur = nxt; cA = nA; cB = nB; ++ui;
        if (wr == 1) PG8_BAR;
    }
    PG8_WAIT_V(0);
    PG8_BAR;
#undef PG8_SA
#undef PG8_SB
#undef PG8_STAGE
#undef PG8_LDA
#undef PG8_LDB
#undef PG8_MMA
#undef PG8_WAIT_V
#undef PG8_WAIT_L
#undef PG8_BAR
#undef PG8_SCHED
}
}

typedef f32x4 AccT[2][2][4][2];

struct Params {
    const float* in[27];
    float* out; unsigned char* ws;
    int ph_lo, ph_hi, flags, pad1;
};

__device__ __forceinline__ u32x4 pack8(const f32x4 a, const f32x4 b) { u32x4 w; w.x = pk2(a[0], a[1]); w.y = pk2(a[2], a[3]); w.z = pk2(b[0], b[1]); w.w = pk2(b[2], b[3]); return w; }

#define EPI_ROWS_BEGIN _Pragma("unroll") for (int ai = 0; ai < 2; ++ai) _Pragma("unroll") for (int m = 0; m < 4; ++m) { int rowi = row0 + ai * 128 + m * 16; asm volatile("" : "+v"(rowi)); const size_t row = (size_t)rowi;
#define EPI_ROWS_END asm volatile("" ::: "memory"); }
#define EPI_RS const float rs_ = rss ? rsqrtf(rss[row] * (1.0f / DM) + NORM_EPS) : 1.0f;
struct EpiGLU {
    static constexpr bool PERM = true; bf16_t* U; const float* rss;
    __device__ __forceinline__ void operator()(const AccT& acc, const pg8::Unit& u, int wr, int wc, int fr, int fq) const {
        const int row0 = u.pm * 256 + wr * 64 + fr; bf16_t* d = U + u.pn * 128 + wc * 32 + 8 * fq;
        EPI_ROWS_BEGIN EPI_RS f32x4 o0, o1;
#pragma unroll
            for (int e = 0; e < 4; ++e) { o0[e] = (acc[ai][0][m][0][e] * rs_) * sigmoidf_(acc[ai][1][m][0][e] * rs_); o1[e] = (acc[ai][0][m][1][e] * rs_) * sigmoidf_(acc[ai][1][m][1][e] * rs_); }
            *(u32x4*)(d + row * DCONV) = pack8(o0, o1);
        EPI_ROWS_END
    }
};
struct EpiRnnIn {
    static constexpr bool PERM = true; bf16_t *RX, *GG; const float* rss;
    __device__ __forceinline__ void operator()(const AccT& acc, const pg8::Unit& u, int wr, int wc, int fr, int fq) const {
        const int row0 = u.pm * 256 + wr * 64 + fr; const bool isg = u.pn >= 3; bf16_t* d = (isg ? GG + (u.pn - 3) * 256 : RX + u.pn * 256) + wc * 32 + 8 * fq;
        EPI_ROWS_BEGIN EPI_RS
#pragma unroll
            for (int bj = 0; bj < 2; ++bj) { f32x4 o0 = acc[ai][bj][m][0] * rs_, o1 = acc[ai][bj][m][1] * rs_;
                if (isg) {
#pragma unroll
                    for (int e = 0; e < 4; ++e) { o0[e] = gelu_tanh(o0[e]); o1[e] = gelu_tanh(o1[e]); } }
                *(u32x4*)(d + row * DRNN + bj * 128) = pack8(o0, o1); }
        EPI_ROWS_END
    }
};
struct EpiRope {
    static constexpr bool PERM = true; bf16_t *Q, *QR, *KSLC, *KWIN; const f32x2* ROPE; const float* rss;
    __device__ __forceinline__ void operator()(const AccT& acc, const pg8::Unit& u, int wr, int wc, int fr, int fq) const {
        const int row0 = u.pm * 256 + wr * 64 + fr, cc = wc * 32 + 8 * fq, hh = cc >> 6, i0 = cc & 63; const bool isq = u.pn < 3;
        bf16_t* d0; bf16_t* dq = Q; int pitch; float sc;
        if (isq) { const int head = 2 * u.pn + hh; d0 = QR + head * 128 + i0; dq = Q + head * 128 + i0; pitch = DATT; sc = C2; }
        else { d0 = (u.pn == 3 ? KSLC : KWIN) + (size_t)hh * T_ * 128 + i0; pitch = 128; sc = 1.0f; }
        EPI_ROWS_BEGIN EPI_RS const float scr_ = sc * rs_; const f32x2* rp = ROPE + (rowi & (SEQ - 1)) * 64 + i0;
#pragma unroll
            for (int n = 0; n < 2; ++n) { const f32x4 x1 = acc[ai][0][m][n] * scr_, x2 = acc[ai][1][m][n] * scr_; f32x4 r1, r2;
#pragma unroll
                for (int e = 0; e < 4; ++e) { const f32x2 cs = rp[4 * n + e]; r1[e] = x1[e] * cs.x - x2[e] * cs.y; r2[e] = x2[e] * cs.x + x1[e] * cs.y; }
                u32x2 w; w.x = pk2(r1[0], r1[1]); w.y = pk2(r1[2], r1[3]); *(u32x2*)(d0 + row * pitch + 4 * n) = w;
                w.x = pk2(r2[0], r2[1]); w.y = pk2(r2[2], r2[3]); *(u32x2*)(d0 + row * pitch + 64 + 4 * n) = w;
                if (isq) { w.x = pk2(x1[0], x1[1]); w.y = pk2(x1[2], x1[3]); *(u32x2*)(dq + row * pitch + 4 * n) = w;
                           w.x = pk2(x2[0], x2[1]); w.y = pk2(x2[2], x2[3]); *(u32x2*)(dq + row * pitch + 64 + 4 * n) = w; } }
        EPI_ROWS_END
    }
};
struct EpiKV {
    static constexpr bool PERM = true; bf16_t *KCMP, *VCMP, *VSLC, *VWIN; const float* rss;
    __device__ __forceinline__ void operator()(const AccT& acc, const pg8::Unit& u, int wr, int wc, int fr, int fq) const {
        const int row0 = u.pm * 256 + wr * 64 + fr; bf16_t* d = (u.pn == 0 ? KCMP : u.pn == 1 ? VCMP : u.pn == 2 ? VSLC : VWIN) + wc * 32 + 8 * fq; const size_t hs = (u.pn <= 1 ? (size_t)KVROWS : (size_t)T_) * 128;
        EPI_ROWS_BEGIN EPI_RS
#pragma unroll
            for (int bj = 0; bj < 2; ++bj) *(u32x4*)(d + bj * hs + row * 128) = pack8(acc[ai][bj][m][0] * rs_, acc[ai][bj][m][1] * rs_);
        EPI_ROWS_END
    }
};
struct EpiGates {
    static constexpr bool PERM = true; bf16_t* GATES; float* CG; const float* rss;
    __device__ __forceinline__ void operator()(const AccT& acc, const pg8::Unit& u, int wr, int wc, int fr, int fq) const {
        const int row0 = u.pm * 256 + wr * 64 + fr;
        if (u.pn == 0) {
            if (wc == 0 && fq < 3) {
                EPI_ROWS_BEGIN EPI_RS
#pragma unroll
                    for (int e = 0; e < 8; ++e) { const int col = 8 * fq + e; if (col < 18) CG[row * 18 + col] = sigmoidf_(acc[ai][0][m][e >> 2][e & 3] * rs_); }
                EPI_ROWS_END
            }
            return;
        }
        const int gi = u.pn - 1; bf16_t* d = GATES + (size_t)(gi >> 3) * T_ * DM + (gi & 7) * 256 + wc * 32 + 8 * fq;
        EPI_ROWS_BEGIN EPI_RS
#pragma unroll
            for (int bj = 0; bj < 2; ++bj) { f32x4 o0, o1;
#pragma unroll
                for (int e = 0; e < 4; ++e) { o0[e] = sigmoidf_(acc[ai][bj][m][0][e] * rs_); o1[e] = sigmoidf_(acc[ai][bj][m][1][e] * rs_); }
                *(u32x4*)(d + row * DM + bj * 128) = pack8(o0, o1); }
        EPI_ROWS_END
    }
};

template <bool FIRST> struct EpiMerge {
    static constexpr bool PERM = true;
    bf16_t* Y; const bf16_t* G;
    __device__ __forceinline__ void operator()(const AccT& acc, const pg8::Unit& u, int wr, int wc, int fr, int fq) const {
        const int row0 = u.pm * 256 + wr * 64 + fr, c0 = u.pn * 256 + wc * 32 + 8 * fq;
#pragma unroll
        for (int ai = 0; ai < 2; ++ai)
#pragma unroll
            for (int m = 0; m < 4; ++m) { int rowi = row0 + ai * 128 + m * 16; asm volatile("" : "+v"(rowi)); const size_t row = rowi;
#pragma unroll
                for (int bj = 0; bj < 2; ++bj) { const size_t off = row * DM + c0 + bj * 128; const u32x4 g = *(const u32x4*)(G + off); u32x4 y = {0u, 0u, 0u, 0u}; if (!FIRST) y = *(const u32x4*)(Y + off);
                    f32x4 o0, o1; const f32x4 a0 = acc[ai][bj][m][0], a1 = acc[ai][bj][m][1];
                    o0[0] = bflo(y.x) + bflo(g.x) * a0[0]; o0[1] = bfhi(y.x) + bfhi(g.x) * a0[1]; o0[2] = bflo(y.y) + bflo(g.y) * a0[2]; o0[3] = bfhi(y.y) + bfhi(g.y) * a0[3];
                    o1[0] = bflo(y.z) + bflo(g.z) * a1[0]; o1[1] = bfhi(y.z) + bfhi(g.z) * a1[1]; o1[2] = bflo(y.w) + bflo(g.w) * a1[2]; o1[3] = bfhi(y.w) + bfhi(g.w) * a1[3];
                    *(u32x4*)(Y + off) = pack8(o0, o1); }
                asm volatile("" ::: "memory"); }
    }
};

struct EpiResid {
    static constexpr bool PERM = false;
    const float* xin; float* xout; bf16_t* xb; float* rss;
    __device__ __forceinline__ void operator()(const AccT& acc, const pg8::Unit& u, int wr, int wc, int fr, int fq) const {
        const int row0 = u.pm * 256 + wr * 64 + fr, c0 = u.pn * 256 + wc * 32 + 4 * fq, lane = fq * 16 + fr;
#pragma unroll
        for (int ai = 0; ai < 2; ++ai)
#pragma unroll
            for (int m = 0; m < 4; ++m) { int rowi = row0 + ai * 128 + m * 16; asm volatile("" : "+v"(rowi)); const size_t row = rowi; float ss = 0.f;
#pragma unroll
                for (int bj = 0; bj < 2; ++bj)
#pragma unroll
                    for (int n = 0; n < 2; ++n) { const size_t off = row * DM + c0 + bj * 128 + n * 16; const f32x4 xv = *(const f32x4*)(xin + off); const f32x4 r = xv + acc[ai][bj][m][n]; *(f32x4*)(xout + off) = r;
                        if (xb) { u32x2 w; w.x = pk2(r[0], r[1]); w.y = pk2(r[2], r[3]); *(u32x2*)(xb + off) = w; ss += (r[0] * r[0] + r[1] * r[1]) + (r[2] * r[2] + r[3] * r[3]); } }
                if (xb) { ss += shx(ss, 16, lane); ss += shx(ss, 32, lane); if (fq == 0) __hip_atomic_fetch_add(rss + row, ss, __ATOMIC_RELAXED, __HIP_MEMORY_SCOPE_AGENT); }
                asm volatile("" ::: "memory"); }
    }
};

struct EpiRelu2 {
    static constexpr bool PERM = true;
    bf16_t* Hd; const float* rss;
    __device__ __forceinline__ void operator()(const AccT& acc, const pg8::Unit& u, int wr, int wc, int fr, int fq) const {
        const int row0 = u.pm * 256 + wr * 64 + fr, c0 = u.pn * 256 + wc * 32 + 8 * fq;
#pragma unroll
        for (int ai = 0; ai < 2; ++ai)
#pragma unroll
            for (int m = 0; m < 4; ++m) { int rowi = row0 + ai * 128 + m * 16; asm volatile("" : "+v"(rowi)); const size_t row = rowi; const float rs_ = rsqrtf(rss[row] * (1.0f / DM) + NORM_EPS);
#pragma unroll
                for (int bj = 0; bj < 2; ++bj) { f32x4 o0 = acc[ai][bj][m][0] * rs_, o1 = acc[ai][bj][m][1] * rs_;
#pragma unroll
                    for (int e = 0; e < 4; ++e) { const float a = fmaxf(o0[e], 0.f), b = fmaxf(o1[e], 0.f); o0[e] = a * a; o1[e] = b * b; }
                    *(u32x4*)(Hd + row * DFF + c0 + bj * 128) = pack8(o0, o1); } }
    }
};

__device__ __forceinline__ float expm1_small(float y) {
    return y * (1.0f + y * (0.5f + y * (0.16666667f + y * (0.041666668f + y * (0.0083333338f + y * 0.0013888889f)))));
}
struct EpiGate {
    static constexpr bool PERM = true;
    const bf16_t* XC; float* Aout; float* Bout; const float *ba, *bx, *spc;
    __device__ __forceinline__ void operator()(const AccT& acc, const pg8::Unit& u, int wr, int wc, int fr, int fq) const {
        const int row0 = u.pm * 256 + wr * 64 + fr, ch0 = u.pn * 128 + wc * 32 + 8 * fq;
        EPI_ROWS_BEGIN
#pragma unroll
            for (int n = 0; n < 2; ++n) { const int ch = ch0 + 4 * n; f32x4 tq4;
                { const f32x4 sp = *(const f32x4*)(spc + ch), bav = *(const f32x4*)(ba + ch); f32x4 av;
#pragma unroll
                  for (int e = 0; e < 4; ++e) { const float la = sp[e] * sigmoidf_(acc[ai][0][m][n][e] + bav[e]); av[e] = 1.0f + expm1_small(la); tq4[e] = __builtin_amdgcn_sqrtf(fmaxf(-expm1_small(2.0f * la), 0.f)); }
                  *(f32x4*)(Aout + row * DRNN + ch) = av; }
                asm volatile("" ::: "memory");
                { const f32x4 bxv = *(const f32x4*)(bx + ch); const u32x2 xw = *(const u32x2*)(XC + row * DRNN + ch); f32x4 bv;
                  bv[0] = tq4[0] * (sigmoidf_(acc[ai][1][m][n][0] + bxv[0]) * bflo(xw.x)); bv[1] = tq4[1] * (sigmoidf_(acc[ai][1][m][n][1] + bxv[1]) * bfhi(xw.x));
                  bv[2] = tq4[2] * (sigmoidf_(acc[ai][1][m][n][2] + bxv[2]) * bflo(xw.y)); bv[3] = tq4[3] * (sigmoidf_(acc[ai][1][m][n][3] + bxv[3]) * bfhi(xw.y));
                  *(f32x4*)(Bout + row * DRNN + ch) = bv; }
                asm volatile("" ::: "memory"); }
        EPI_ROWS_END
    }
};

struct EpiCmp {
    static constexpr bool PERM = false;
    float* PART;
    __device__ __forceinline__ void operator()(const AccT& acc, const pg8::Unit& u, int wr, int wc, int fr, int fq) const {
        const int kvh = u.pn >> 3, split = u.pn & 7, row0 = u.pm * 256 + wr * 64 + fr, c0 = wc * 32 + 4 * fq;
        float* base = PART + (size_t)(split * 4 + kvh) * 1024 * 128;
#pragma unroll
        for (int ai = 0; ai < 2; ++ai)
#pragma unroll
            for (int m = 0; m < 4; ++m) { int rowi = row0 + ai * 128 + m * 16; asm volatile("" : "+v"(rowi)); const size_t row = rowi;
#pragma unroll
                for (int n = 0; n < 2; ++n) *(f32x4*)(base + row * 128 + c0 + n * 16) = acc[ai][0][m][n]; }
    }
};

struct GateSched {
    const char* XC; const char* WG; int G, c;
    __device__ bool next(int i, pg8::Unit& u) const { const int L = i * G + c; if (L >= 64 * 6) return false; u.pm = L / 6; u.pn = L % 6;
        u.a = XC + ((size_t)u.pm * 256 * DRNN + u.pn * 128) * 2; u.b = WG + (size_t)u.pn * 256 * 128 * 2; return true; }
};
struct CmpSched {
    const char* KCMP; const char* VCMP; const char* W1K; const char* W1V; int G, c;
    __device__ bool next(int i, pg8::Unit& u) const { const int L = i * G + c; if (L >= 128) return false; const int split = L & 7, pm = (L >> 3) & 3, kvh = L >> 5, kv = kvh >> 1, h = kvh & 1;
        u.pm = pm; u.pn = kvh * 8 + split;
        u.a = (kv ? VCMP : KCMP) + ((size_t)h * KVROWS * 128 + (size_t)pm * 256 * 2048 + split * 512) * 2; u.b = (kv ? W1V : W1K) + (size_t)split * 512 * 2; return true; }
};

#define XB_TMO      128
#define XB_XCNT(j)  (256  + 64 * (j))
#define XB_XSUB(j)  (1280 + 64 * (j))
#define XB_XGEN(j)  (2304 + 64 * (j))
#define XB_TOP      3328
#define XB_TOPGEN   3392
#define XCD_BAR_WORDS 3456
#define XB_SPIN_CAP (1u << 18)

__device__ __forceinline__ unsigned xb_ld(unsigned* p)              { return __hip_atomic_load(p, __ATOMIC_RELAXED, __HIP_MEMORY_SCOPE_AGENT); }
__device__ __forceinline__ unsigned xb_add(unsigned* p, unsigned v) { return __hip_atomic_fetch_add(p, v, __ATOMIC_RELAXED, __HIP_MEMORY_SCOPE_AGENT); }
__device__ __forceinline__ unsigned xb_xcc_id() { return (unsigned)__builtin_amdgcn_s_getreg((3 << 11) | 20) & 0xFu; }
#define XB_SPIN(cond, bar) do { unsigned _sp = 0; while (cond) { __builtin_amdgcn_s_sleep(1); \
    if ((++_sp & 255u) == 0u) { if (xb_ld(&(bar)[XB_TMO])) break; if (_sp > XB_SPIN_CAP) { atomicAdd(&(bar)[XB_TMO], 1u); break; } } } } while (0)

struct XcdBarrier {
    unsigned* bar; unsigned x;
    volatile LAS unsigned* st;
};

__device__ __forceinline__ XcdBarrier xcd_barrier_post(unsigned* bar, volatile LAS unsigned* st) {
    XcdBarrier b; b.bar = bar; b.x = xb_xcc_id(); b.st = st;
    if (threadIdx.x == 0) (void)xb_add(&bar[XB_XCNT(b.x)], 1u);
    return b;
}
__device__ __forceinline__ void xcd_barrier_complete(unsigned* bar, unsigned x, unsigned& nloc, unsigned& nx) {
    const unsigned G = gridDim.x * gridDim.y * gridDim.z;
    unsigned sum, cnt, mine, sp = 0u;
    for (;;) {
        sum = 0u; cnt = 0u; mine = 0u;
#pragma unroll
        for (unsigned j = 0; j < 16; ++j) { const unsigned c = xb_ld(&bar[XB_XCNT(j)]); sum += c; cnt += (c > 0u) ? 1u : 0u; mine = (j == x) ? c : mine; }
        if (sum == G) break;
        __builtin_amdgcn_s_sleep(1);
        if ((++sp & 255u) == 0u) { if (xb_ld(&bar[XB_TMO])) break; if (sp > XB_SPIN_CAP) { atomicAdd(&bar[XB_TMO], 1u); break; } }
    }
    nloc = mine > 0u ? mine : 1u; nx = cnt > 0u ? cnt : 1u;
}

__device__ __forceinline__ void xcd_barrier(const XcdBarrier& b) {
    asm volatile("s_waitcnt vmcnt(0)" ::: "memory");
    __syncthreads();
    if (threadIdx.x == 0) {
        unsigned* bar = b.bar;
        __builtin_amdgcn_s_waitcnt(0);
        unsigned nloc = b.st[0], nx = b.st[1];
        if (nloc == 0u) { xcd_barrier_complete(bar, b.x, nloc, nx); b.st[0] = nloc; b.st[1] = nx; }
        const unsigned old = xb_add(&bar[XB_XSUB(b.x)], 1u);
        const unsigned gen = old / nloc;
        if (old + 1u == (gen + 1u) * nloc) {
            __builtin_amdgcn_fence(__ATOMIC_RELEASE, "agent");
            asm volatile("s_waitcnt vmcnt(0)" ::: "memory");
            const unsigned og = xb_add(&bar[XB_TOP], 1u);
            const unsigned tg = og / nx;
            if (og + 1u == (tg + 1u) * nx) xb_add(&bar[XB_TOPGEN], 1u);
            else XB_SPIN(xb_ld(&bar[XB_TOPGEN]) == tg, bar);
            __builtin_amdgcn_fence(__ATOMIC_ACQUIRE, "agent");
            xb_add(&bar[XB_XGEN(b.x)], 1u);
            asm volatile("s_waitcnt vmcnt(0)" ::: "memory");
        } else {
            XB_SPIN(xb_ld(&bar[XB_XGEN(b.x)]) == gen, bar);
            __builtin_amdgcn_fence(__ATOMIC_ACQUIRE, "agent");
            asm volatile("s_waitcnt vmcnt(0)" ::: "memory");
        }
    }
    __syncthreads();
}


__device__ __forceinline__ void xcd_census(unsigned* bar_in, volatile LAS unsigned* st) {
    unsigned long long bl_ = (unsigned long long)bar_in; asm volatile("" : "+v"(bl_)); unsigned* bar = (unsigned*)bl_;
    if (threadIdx.x == 0) { const unsigned x = xb_xcc_id(); (void)xb_add(&bar[XB_XCNT(x)], 1u); unsigned nloc, nx; xcd_barrier_complete(bar, x, nloc, nx); st[0] = nloc; st[1] = nx; }
    __syncthreads();
}
__device__ __forceinline__ void xcd_barrier_light(unsigned* bar_in, volatile LAS unsigned* st) {
    unsigned long long bl_ = (unsigned long long)bar_in; asm volatile("" : "+v"(bl_)); unsigned* bar = (unsigned*)bl_;
    asm volatile("s_waitcnt vmcnt(0)" ::: "memory");
    __syncthreads();
    if (threadIdx.x == 0) {
        __builtin_amdgcn_s_waitcnt(0);
        const unsigned x = xb_xcc_id(); const unsigned nloc = st[0], nx = st[1];
        const unsigned old = xb_add(&bar[XB_XSUB(x)], 1u);
        const unsigned gen = old / nloc;
        if (old + 1u == (gen + 1u) * nloc) {
            __builtin_amdgcn_fence(__ATOMIC_RELEASE, "agent");
            asm volatile("s_waitcnt vmcnt(0)" ::: "memory");
            const unsigned og = xb_add(&bar[XB_TOP], 1u);
            const unsigned tg = og / nx;
            if (og + 1u == (tg + 1u) * nx) xb_add(&bar[XB_TOPGEN], 1u);
            else XB_SPIN(xb_ld(&bar[XB_TOPGEN]) == tg, bar);
            __builtin_amdgcn_fence(__ATOMIC_ACQUIRE, "agent");
            xb_add(&bar[XB_XGEN(x)], 1u);
            asm volatile("s_waitcnt vmcnt(0)" ::: "memory");
        } else {
            XB_SPIN(xb_ld(&bar[XB_XGEN(x)]) == gen, bar);
            __builtin_amdgcn_fence(__ATOMIC_ACQUIRE, "agent");
            asm volatile("s_waitcnt vmcnt(0)" ::: "memory");
        }
    }
    __syncthreads();
}

__device__ __forceinline__ int win_src_col(int dr) {
    const int pn = dr >> 8, j = dr & 255;
    if (pn < 4) return (j < 128) ? pn * 128 + j : 512 + pn * 128 + (j - 128);
    if (pn < 7) return 1024 + (pn - 4) * 256 + j;
    if (pn < 10) return 1792 + (pn - 7) * 256 + j;
    const int rh = (j & 127) >> 6, rd = (j >> 7) * 64 + (j & 63);
    if (pn < 13) return 2560 + (2 * (pn - 10) + rh) * 128 + rd;
    if (pn == 13) return 3840 + rh * 128 + rd;
    if (pn == 14) return 4352 + rh * 128 + rd;
    if (pn == 15) return 3328 + j;
    if (pn == 16) return 3584 + j;
    if (pn == 17) return 4096 + j;
    if (pn == 18) return 4608 + j;
    if (pn == 19) return j < 18 ? 4864 + j : -1;
    return 4882 + (pn - 20) * 256 + j;
}
typedef float f32x4_u __attribute__((ext_vector_type(4), aligned(4)));
template <int MODE> __device__ __forceinline__ void tr_load(f32x4 (&tv)[16], const float* W, int Nsrc, int n0, int k0, int lane, const float* kscale) {
    const int n4 = (lane & 15) * 4, kq = lane >> 4;
    const int dr = n0 + n4; const int sc = MODE ? win_src_col(dr) : (dr < Nsrc ? dr : -1);
    const bool irregular = MODE && (dr >> 8) == 19;
    if (irregular) {
#pragma unroll
        for (int i = 0; i < 16; ++i) { const float* wp = W + (size_t)(k0 + kq + 4 * i) * Nsrc;
#pragma unroll
            for (int e = 0; e < 4; ++e) { const int c = win_src_col(dr + e); tv[i][e] = c >= 0 ? wp[c] : 0.f; } }
    } else if (sc >= 0) {
#pragma unroll
        for (int i = 0; i < 16; ++i) tv[i] = *(const f32x4_u*)(W + (size_t)(k0 + kq + 4 * i) * Nsrc + sc);
    } else {
#pragma unroll
        for (int i = 0; i < 16; ++i) tv[i] = (f32x4){0.f, 0.f, 0.f, 0.f};
    }
    if (kscale) {
#pragma unroll
        for (int i = 0; i < 16; ++i) tv[i] *= kscale[k0 + kq + 4 * i]; }
}
__device__ __forceinline__ void tr_store(const f32x4 (&tv)[16], int K, bf16_t* WT, int n0, int k0, LAS float* scr, int lane) {
    const int n4 = (lane & 15) * 4, kq = lane >> 4;
#pragma unroll
    for (int i = 0; i < 16; ++i) { LAS float* d = scr + (kq + 4 * i) * 65 + n4; d[0] = tv[i][0]; d[1] = tv[i][1]; d[2] = tv[i][2]; d[3] = tv[i][3]; }
    LDS_WAIT(); asm volatile("" ::: "memory");
    const int c = lane & 7;
#pragma unroll
    for (int j = 0; j < 8; ++j) { const int n = (lane >> 3) + 8 * j; const LAS float* sp = scr + (8 * c) * 65 + n;
        u32x4 o; o.x = pk2(sp[0 * 65], sp[1 * 65]); o.y = pk2(sp[2 * 65], sp[3 * 65]); o.z = pk2(sp[4 * 65], sp[5 * 65]); o.w = pk2(sp[6 * 65], sp[7 * 65]);
        *(u32x4*)(WT + (size_t)(n0 + n) * K + k0 + 8 * c) = o; }
    LDS_WAIT(); asm volatile("" ::: "memory");
}
template <int MODE> __device__ __forceinline__ void convert_matrix(const float* W, int K, int Nsrc, int Ndst, bf16_t* WT, LAS float* scr, int lane, int gw, int NGW, const float* kscale = nullptr) {
    const int nblk = Ndst / 64, KB = K / 64, kgs = (KB + 7) / 8, tasks = nblk * kgs, wv = gw & 7, G = NGW >> 3;
    f32x4 cur[16], nxt[16];
    int tt = gw >> 3, nb = 0, kb = 0; bool ok = false;
    if (tt < tasks) { nb = tt % nblk; kb = (tt / nblk) * 8 + wv; ok = kb < KB; if (ok) tr_load<MODE>(cur, W, Nsrc, nb * 64, kb * 64, lane, kscale); }
    while (tt < tasks) {
        const int tn = tt + G; int nb2 = 0, kb2 = 0; bool ok2 = false;
        if (tn < tasks) { nb2 = tn % nblk; kb2 = (tn / nblk) * 8 + wv; ok2 = kb2 < KB; if (ok2) tr_load<MODE>(nxt, W, Nsrc, nb2 * 64, kb2 * 64, lane, kscale); }
        if (ok) tr_store(cur, K, WT, nb * 64, kb * 64, scr, lane);
#pragma unroll
        for (int i = 0; i < 16; ++i) cur[i] = nxt[i];
        tt = tn; nb = nb2; kb = kb2; ok = ok2;
    }
}

typedef __attribute__((address_space(4))) const unsigned char* kaptr_t;
__device__ __forceinline__ unsigned long long karg_u64(int byte_off) { kaptr_t ka = (kaptr_t)__builtin_amdgcn_kernarg_segment_ptr(); asm volatile("" : "+s"(ka)); return *(__attribute__((address_space(4))) const unsigned long long*)(ka + byte_off); }
#define GAS1 __attribute__((address_space(1)))
__device__ __forceinline__ unsigned char* ws_at(const Params& p, size_t off) { asm volatile("" : "+s"(off)); return (unsigned char*)((GAS1 unsigned char*)karg_u64((int)__builtin_offsetof(Params, ws)) + off); }
__device__ __forceinline__ const float* in_at(const Params& p, int i, size_t off) { asm volatile("" : "+s"(off)); return (const float*)((GAS1 const float*)karg_u64(i * 8) + off); }
__device__ __forceinline__ float* out_at(const Params& p) { return (float*)(GAS1 float*)karg_u64((int)__builtin_offsetof(Params, out)); }
__device__ __forceinline__ int fresh_s(int v) { asm volatile("" : "+s"(v)); return v; }
__device__ __forceinline__ int fresh_tid(int wid0) { int w = wid0; asm volatile("" : "+s"(w)); int ln; asm volatile("v_mbcnt_lo_u32_b32 %0, -1, 0\n\tv_mbcnt_hi_u32_b32 %0, -1, %0" : "=&v"(ln)); return w * 64 + ln; }
__global__ void __launch_bounds__(512, 2) fwd_kernel(Params p) {
    extern __shared__ __attribute__((aligned(16))) unsigned char lds_raw[];
    LAS unsigned char* lds = (LAS unsigned char*)lds_raw;
    cg::grid_group grid = cg::this_grid();
    const int wid0 = __builtin_amdgcn_readfirstlane((int)threadIdx.x >> 6);
    const int G0 = gridDim.x, bid0 = blockIdx.x;
#define WSP(T, off) ((T*)ws_at(p, (off)))
#define X (out_at(p))
#define P_ROPE WSP(f32x2, WS_ROPE)
#define P_WIN WSP(bf16_t, WS_WIN)
#define P_WCO WSP(bf16_t, WS_WCO)
#define P_WRO WSP(bf16_t, WS_WRO)
#define P_WAO WSP(bf16_t, WS_WAO)
#define P_WO WSP(bf16_t, WS_WO)
#define P_WUP WSP(bf16_t, WS_WUP)
#define P_WDN WSP(bf16_t, WS_WDN)
#define P_WG WSP(bf16_t, WS_WG)
#define P_W1K WSP(bf16_t, WS_W1K)
#define P_W1V WSP(bf16_t, WS_W1V)
#define P_ACT WSP(bf16_t, WS_ACT)
#define P_HB WSP(bf16_t, WS_H)
#define P_ABUF WSP(float, WS_H)
#define P_YB WSP(bf16_t, WS_H)
#define P_HID WSP(bf16_t, WS_H)
#define P_UB WSP(bf16_t, WS_U)
#define P_RX WSP(bf16_t, WS_R1 + 16 * MiB)
#define P_BBUF WSP(float, WS_R1)
#define P_TMPO WSP(float, WS_R1)
#define P_XC WSP(bf16_t, WS_XC)
#define P_OC WSP(bf16_t, WS_XC)
#define P_GG WSP(bf16_t, WS_GG)
#define P_QB WSP(bf16_t, WS_Q)
#define P_QR WSP(bf16_t, WS_QR)
#define P_KCMP WSP(bf16_t, WS_KCMP)
#define P_VCMP WSP(bf16_t, WS_VCMP)
#define P_KSLC WSP(bf16_t, WS_KSLC)
#define P_VSLC WSP(bf16_t, WS_VSLC)
#define P_KWIN WSP(bf16_t, WS_KWIN)
#define P_VWIN WSP(bf16_t, WS_VWIN)
#define P_CG WSP(float, WS_CG)
#define P_GATES WSP(bf16_t, WS_GATES)
#define P_PART WSP(float, WS_PART)
#define P_KC WSP(float, WS_KC)
#define P_VC WSP(float, WS_VC)
#define P_SEL WSP(unsigned, WS_SEL)
#define P_BPART WSP(float, WS_CTL + CTL_BPART)
#define P_SPC WSP(float, WS_CTL + CTL_SPC)
#define P_RSS WSP(float, WS_CTL + CTL_RSS)

#ifndef ENABLE_MASK
#define ENABLE_MASK 0xffffu
#endif
    {
        if (threadIdx.x < 2) ((LAS unsigned*)(lds + LDS_BYTES - 16))[threadIdx.x] = 0u;
        __syncthreads(); }
    xcd_census((unsigned*)ws_at(p, WS_CTL + CTL_BAR), (volatile LAS unsigned*)(lds + LDS_BYTES - 16));
    int phase = 0;
#define PH_BEGIN(k) if (((ENABLE_MASK >> (k)) & 1u) && phase >= p.ph_lo && phase < p.ph_hi) { \
        const int tid = fresh_tid(wid0); const int lane = tid & 63; const int wid = fresh_s(wid0), G = fresh_s(G0), bid = fresh_s(bid0); const int gw = bid * 8 + wid, NGW = G * 8; \
        (void)tid; (void)lane; (void)gw; (void)NGW;
#define PH_END   if (phase + 1 < p.ph_hi) { if (p.ph_hi < 0) grid.sync();   else xcd_barrier_light((unsigned*)ws_at(p, WS_CTL + CTL_BAR), (volatile LAS unsigned*)(lds + LDS_BYTES - 16)); } } ++phase;

    for (int l = 0; l < NLAYER; ++l) {
        const size_t lz = (size_t)l;
#define P_xin ((l == 0) ? in_at(p, 0, 0) : (const float*)X)
#define P_attn_norm_g in_at(p, 1, lz * DM)
#define P_w_in in_at(p, 2, lz * DM * NIN)
#define P_conv_dw_w in_at(p, 3, lz * 31 * DCONV)
#define P_conv_dw_b in_at(p, 4, lz * DCONV)
#define P_conv_ln_g in_at(p, 5, lz * DCONV)
#define P_conv_ln_b in_at(p, 6, lz * DCONV)
#define P_w_conv_out in_at(p, 7, lz * DCONV * DM)
#define P_rnn_conv_w in_at(p, 8, lz * 4 * DRNN)
#define P_rnn_conv_b in_at(p, 9, lz * DRNN)
#define P_rglru_wa in_at(p, 10, lz * 6 * 128 * 128)
#define P_rglru_ba in_at(p, 11, lz * DRNN)
#define P_rglru_wx in_at(p, 12, lz * 6 * 128 * 128)
#define P_rglru_bx in_at(p, 13, lz * DRNN)
#define P_rglru_lambda in_at(p, 14, lz * DRNN)
#define P_w_rnn_out in_at(p, 15, lz * DRNN * DM)
#define P_cmp_pe in_at(p, 16, lz * 32 * 128)
#define P_cmp_k_w1 in_at(p, 17, lz * 4096 * 128)
#define P_cmp_k_w2 in_at(p, 18, lz * 128 * 128)
#define P_cmp_v_w1 in_at(p, 19, lz * 4096 * 128)
#define P_cmp_v_w2 in_at(p, 20, lz * 128 * 128)
#define P_w_attn_out in_at(p, 21, lz * DATT * DM)
#define P_w_o in_at(p, 22, lz * DM * DM)
#define P_mlp_norm_g in_at(p, 23, lz * DM)
#define P_w_mlp_up in_at(p, 24, lz * DM * DFF)
#define P_w_mlp_down in_at(p, 25, lz * DFF * DM)

        PH_BEGIN(0)
        const auto ROPE = P_ROPE;
        const auto WIN = P_WIN;
        const auto WCO = P_WCO;
        const auto WRO = P_WRO;
        const auto WAO = P_WAO;
        const auto WO = P_WO;
        const auto WUP = P_WUP;
        const auto WDN = P_WDN;
        const auto WG = P_WG;
        const auto W1K = P_W1K;
        const auto W1V = P_W1V;
        const auto HB = P_HB;
        const auto xin = P_xin;
        const auto attn_norm_g = P_attn_norm_g;
        const auto w_in = P_w_in;
        const auto w_conv_out = P_w_conv_out;
        const auto rglru_wa = P_rglru_wa;
        const auto rglru_wx = P_rglru_wx;
        const auto w_rnn_out = P_w_rnn_out;
        const auto cmp_k_w1 = P_cmp_k_w1;
        const auto cmp_v_w1 = P_cmp_v_w1;
        const auto w_attn_out = P_w_attn_out;
        const auto w_o = P_w_o;
        const auto mlp_norm_g = P_mlp_norm_g;
        const auto w_mlp_up = P_w_mlp_up;
        const auto w_mlp_down = P_w_mlp_down;
        {
            LAS float* scr = (LAS float*)(lds + wid * 16640);
            convert_matrix<1>(w_in, DM, NIN, NINP, WIN, scr, lane, gw, NGW, attn_norm_g);
            convert_matrix<0>(w_mlp_up, DM, DFF, DFF, WUP, scr, lane, gw, NGW, mlp_norm_g);
            convert_matrix<0>(w_mlp_down, DFF, DM, DM, WDN, scr, lane, gw, NGW);
            convert_matrix<0>(w_o, DM, DM, DM, WO, scr, lane, gw, NGW);
            convert_matrix<0>(w_conv_out, DCONV, DM, DM, WCO, scr, lane, gw, NGW);
            convert_matrix<0>(w_rnn_out, DRNN, DM, DM, WRO, scr, lane, gw, NGW);
            convert_matrix<0>(w_attn_out, DATT, DM, DM, WAO, scr, lane, gw, NGW);
            convert_matrix<0>(cmp_k_w1, 4096, 128, 256, W1K, scr, lane, gw, NGW);
            convert_matrix<0>(cmp_v_w1, 4096, 128, 256, W1V, scr, lane, gw, NGW);
            for (int n = 0; n < 6; ++n) {
                convert_matrix<0>(rglru_wa + n * 16384, 128, 128, 128, WG + n * 256 * 128, scr, lane, gw, NGW);
                convert_matrix<0>(rglru_wx + n * 16384, 128, 128, 128, WG + n * 256 * 128 + 128 * 128, scr, lane, gw, NGW);
            }
            { const auto lam_ = P_rglru_lambda; const auto spc_ = P_SPC;
              for (int e = bid * 512 + tid; e < DRNN; e += G * 512) { const float ex = __expf(-lam_[e]);
                  spc_[e] = -8.0f * (ex * (1.0f + ex * (-0.5f + ex * (0.33333334f + ex * (-0.25f + ex * 0.2f))))); } }
            if (l == 0) {
                for (int e = bid * 512 + tid; e < SEQ * 64; e += G * 512) { const int pos = e >> 6, i = e & 63;
                    const float inv = __builtin_amdgcn_exp2f(-(float)i * 0.20762050593046014f);
                    const float rev = ((float)pos * inv) * 0.15915494309189535f; const float fr_ = rev - floorf(rev);
                    ROPE[e] = (f32x2){__builtin_amdgcn_cosf(fr_), __builtin_amdgcn_sinf(fr_)}; }
            }
            if (l == 0) for (int m = gw; m < T_; m += NGW) { const f32x4* xr = (const f32x4*)(xin + (size_t)m * DM) + lane; f32x4 v[8]; float s = 0.f;
#pragma unroll
                for (int j = 0; j < 8; ++j) { v[j] = xr[64 * j]; s += (v[j].x * v[j].x + v[j].y * v[j].y) + (v[j].z * v[j].z + v[j].w * v[j].w); }
                const float rstd = rsqrtf(wave_sum(s, lane) * (1.f / DM) + NORM_EPS);
                u32x2* o8 = (u32x2*)(HB + (size_t)m * DM) + lane;
#pragma unroll
                for (int j = 0; j < 8; ++j) { u32x2 w; w.x = pk2(v[j].x * rstd, v[j].y * rstd); w.y = pk2(v[j].z * rstd, v[j].w * rstd); o8[64 * j] = w; }
            }
            __syncthreads();
        }
        PH_END

        PH_BEGIN(1)
        const auto ROPE = P_ROPE;
        const auto WIN = P_WIN;
        const auto HB = P_HB;
        const auto UB = P_UB;
        const auto RX = P_RX;
        const auto GG = P_GG;
        const auto QB = P_QB;
        const auto QR = P_QR;
        const auto KCMP = P_KCMP;
        const auto VCMP = P_VCMP;
        const auto KSLC = P_KSLC;
        const auto VSLC = P_VSLC;
        const auto KWIN = P_KWIN;
        const auto VWIN = P_VWIN;
        const auto CG = P_CG;
        const auto GATES = P_GATES;
        {
            const bf16_t* Ain = (l == 0) ? (const bf16_t*)HB : (const bf16_t*)P_ACT; const float* rss = (l == 0) ? (const float*)nullptr : (const float*)(P_RSS + (size_t)(2 * (l - 1) + 1) * T_);
            { pg8::StdSched S; S.init(Ain, DM, WIN, DM, T_, 4 * 256, G, bid); EpiGLU E{UB, rss}; pg8::gemm_phase(lds, tid, DM, DM, DM, S, E); }
            { pg8::StdSched S; S.init(Ain, DM, WIN + (size_t)4 * 256 * DM, DM, T_, 6 * 256, G, bid); EpiRnnIn E{RX, GG, rss}; pg8::gemm_phase(lds, tid, DM, DM, DM, S, E); }
            { pg8::StdSched S; S.init(Ain, DM, WIN + (size_t)10 * 256 * DM, DM, T_, 5 * 256, G, (bid + 128) % G); EpiRope E{QB, QR, KSLC, KWIN, ROPE, rss}; pg8::gemm_phase(lds, tid, DM, DM, DM, S, E); }
            { pg8::StdSched S; S.init(Ain, DM, WIN + (size_t)15 * 256 * DM, DM, T_, 4 * 256, G, bid); EpiKV E{KCMP, VCMP, VSLC, VWIN, rss}; pg8::gemm_phase(lds, tid, DM, DM, DM, S, E); }
            { pg8::StdSched S; S.init(Ain, DM, WIN + (size_t)19 * 256 * DM, DM, T_, 25 * 256, G, (bid + 64) % G); EpiGates E{GATES, CG, rss}; pg8::gemm_phase(lds, tid, DM, DM, DM, S, E); }
        }
        PH_END

        PH_BEGIN(2)
        const auto W1K = P_W1K;
        const auto W1V = P_W1V;
        const auto RX = P_RX;
        const auto XC = P_XC;
        const auto KCMP = P_KCMP;
        const auto VCMP = P_VCMP;
        const auto PART = P_PART;
        const auto BPART = P_BPART;
        const auto rnn_conv_w = P_rnn_conv_w;
        const auto rnn_conv_b = P_rnn_conv_b;
        const auto cmp_pe = P_cmp_pe;
        const auto cmp_k_w1 = P_cmp_k_w1;
        const auto cmp_v_w1 = P_cmp_v_w1;
        {
            { CmpSched S{(const char*)KCMP, (const char*)VCMP, (const char*)W1K, (const char*)W1V, G, bid}; EpiCmp E{PART}; pg8::gemm_phase(lds, tid, 512, 2048, 4096, S, E); }
            __syncthreads();
            for (size_t e = (size_t)bid * 512 + tid; e < (size_t)T_ * DRNN / 8; e += (size_t)G * 512) {
                const int row = (int)(e / (DRNN / 8)), c0 = (int)(e % (DRNN / 8)) * 8, pos = row & (SEQ - 1);
                float o[8];
#pragma unroll
                for (int i = 0; i < 8; ++i) o[i] = rnn_conv_b[c0 + i];
#pragma unroll
                for (int j = 0; j < 4; ++j) { if (pos - 3 + j >= 0) { const u32x4 xw = *(const u32x4*)(RX + (size_t)(row - 3 + j) * DRNN + c0); const float* wj = rnn_conv_w + j * DRNN + c0;
                        o[0] += wj[0] * bflo(xw.x); o[1] += wj[1] * bfhi(xw.x); o[2] += wj[2] * bflo(xw.y); o[3] += wj[3] * bfhi(xw.y);
                        o[4] += wj[4] * bflo(xw.z); o[5] += wj[5] * bfhi(xw.z); o[6] += wj[6] * bflo(xw.w); o[7] += wj[7] * bfhi(xw.w); } }
                u32x4 w; w.x = pk2(o[0], o[1]); w.y = pk2(o[2], o[3]); w.z = pk2(o[4], o[5]); w.w = pk2(o[6], o[7]);
                *(u32x4*)(XC + (size_t)row * DRNN + c0) = w;
            }
            {
                LAS float* red = (LAS float*)lds;
                for (int item = bid - 128; item >= 0 && item < 32; item += G) { const int kv = item >> 4, kc = item & 15, kg = tid >> 7, j = tid & 127; const float* w1 = kv ? cmp_v_w1 : cmp_k_w1;
                    float s = 0.f;
#pragma unroll 16
                    for (int i = 0; i < 64; ++i) { const int k = kc * 256 + kg * 64 + i; s += cmp_pe[k] * w1[(size_t)k * 128 + j]; }
                    red[kg * 128 + j] = s; __syncthreads();
                    if (tid < 128) BPART[(kc * 2 + kv) * 128 + tid] = (red[tid] + red[128 + tid]) + (red[256 + tid] + red[384 + tid]);
                    __syncthreads(); }
            }
        }
        PH_END

        PH_BEGIN(3)
        const auto WG = P_WG;
        const auto ABUF = P_ABUF;
        const auto BBUF = P_BBUF;
        const auto XC = P_XC;
        const auto PART = P_PART;
        const auto KC = P_KC;
        const auto VC = P_VC;
        const auto BPART = P_BPART;
        const auto rglru_ba = P_rglru_ba;
        const auto rglru_bx = P_rglru_bx;
        const auto cmp_k_w2 = P_cmp_k_w2;
        const auto cmp_v_w2 = P_cmp_v_w2;
        {
            { const auto SPC = P_SPC; GateSched S{(const char*)XC, (const char*)WG, G, bid}; EpiGate E{XC, ABUF, BBUF, rglru_ba, rglru_bx, SPC}; pg8::gemm_phase(lds, tid, 128, DRNN, 128, S, E); }
            __syncthreads();
            {
                                                                LAS float* hv = (LAS float*)lds;
                const int tid = fresh_tid(wid0); const int rr = tid >> 7, j = tid & 127;
                for (int it = bid; it < 1024; it += G) { const int r4 = it * 4 + rr, n = r4 & 127, h = (r4 >> 7) & 1, b = (r4 >> 8) & 7, kv = r4 >> 11;
                    float s = 0.f;
#pragma unroll
                    for (int sp = 0; sp < 8; ++sp) s += PART[((size_t)(sp * 4 + kv * 2 + h) * 1024 + b * 128 + n) * 128 + j];
#pragma unroll
                    for (int kc = 0; kc < 16; ++kc) s += BPART[(kc * 2 + kv) * 128 + j];
                    hv[rr * 128 + j] = gelu_tanh(s); __syncthreads();
                    const float* w2 = kv ? cmp_v_w2 : cmp_k_w2; float o = 0.f;
#pragma unroll 8
                    for (int k = 0; k < 128; ++k) o += hv[rr * 128 + k] * w2[k * 128 + j];
                    (kv ? VC : KC)[((size_t)(b * 2 + h) * 128 + n) * 128 + j] = (n < 127) ? o : 0.f;
                    __syncthreads(); }
            }
        }
        PH_END

        PH_BEGIN(5)
        const auto ACT = P_ACT;
        const auto OC = P_OC;
        const auto QB = P_QB;
        const auto QR = P_QR;
        const auto KSLC = P_KSLC;
        const auto VSLC = P_VSLC;
        const auto KWIN = P_KWIN;
        const auto VWIN = P_VWIN;
        const auto CG = P_CG;
        const auto KC = P_KC;
        const auto VC = P_VC;
        const auto SEL = P_SEL;
        {
            constexpr int KS_PITCH = 272, KS_BYTES = 64 * KS_PITCH, VT_PITCH = 288, VT_BYTES = 64 * VT_PITCH, QW_BYTES = 48 * KS_PITCH;
            LAS unsigned char* ks = lds; LAS unsigned char* vt = lds + KS_BYTES; LAS unsigned char* qw = lds + KS_BYTES + VT_BYTES + wid * QW_BYTES;
            for (int unit = bid; unit < NBATCH * 2 * 16; unit += G) {
                const int cb = 15 - (unit & 15), hkv = (unit >> 4) & 1, b = unit >> 5;
                {
                constexpr int CP = 272;
                LAS unsigned char* ks2 = lds; LAS unsigned char* vt2 = lds + 128 * CP;
                    int tc_ = fresh_tid(wid0); int ln_ = tc_ & 63; const int fr = ln_ & 15, fq = ln_ >> 4;
                    const float* kcg = KC + (size_t)(b * 2 + hkv) * 128 * 128; const float* vcg = VC + (size_t)(b * 2 + hkv) * 128 * 128;
                    bf16x8 qfa[3][4];
                    { const size_t trq_ = (size_t)b * SEQ + cb * 128 + wid * 16 + fr;
#pragma unroll
                      for (int g = 0; g < 3; ++g)
#pragma unroll
                          for (int ds = 0; ds < 4; ++ds) qfa[g][ds] = *(const bf16x8*)(QB + trq_ * DATT + (3 * hkv + g) * 128 + ds * 32 + fq * 8); }
                    __syncthreads();
#pragma unroll
                    for (int i = 0; i < 8; ++i) { const int idx = tc_ + 512 * i; { const int r = idx >> 5, c4 = (idx & 31) * 4; const f32x4 kv4 = *(const f32x4*)(kcg + r * 128 + c4); u32x2 w; w.x = pk2(kv4.x, kv4.y); w.y = pk2(kv4.z, kv4.w); *(LAS u32x2*)(ks2 + r * CP + c4 * 2) = w; }
                        { const int r = idx >> 5, c4 = (idx & 31) * 4; const f32x4 vv = *(const f32x4*)(vcg + r * 128 + c4); u32x2 w; w.x = pk2(vv.x, vv.y); w.y = pk2(vv.z, vv.w); *(LAS u32x2*)(vt2 + r * 288 + c4 * 2) = w; } }
                    __syncthreads();
                    const int tq = cb * 128 + wid * 16 + fr; const size_t trow = (size_t)b * SEQ + tq;
                    int nvis = (tq >= 31) ? ((tq - 31) >> 4) + 1 : 0; if (nvis > 127) nvis = 127;
                    unsigned vm = 0u;
#pragma unroll
                    for (int i = 0; i < 8; ++i)
#pragma unroll
                        for (int jj = 0; jj < 4; ++jj) vm |= ((16 * i + 4 * fq + jj < nvis) ? 1u : 0u) << (i * 4 + jj);
                    f32x4 pall[8];
#pragma unroll
                    for (int i = 0; i < 8; ++i) pall[i] = (f32x4){0.f, 0.f, 0.f, 0.f};
#pragma unroll
                    for (int g = 0; g < 3; ++g) {
                        bf16x8 qf[4];
#pragma unroll
                        for (int ds = 0; ds < 4; ++ds) qf[ds] = qfa[g][ds];
                        f32x4 S[8];
#pragma unroll
                        for (int i = 0; i < 8; ++i) { bf16x8 kf[4];
#pragma unroll
                            for (int ds = 0; ds < 4; ++ds) kf[ds] = *(const LAS bf16x8*)(ks2 + (i * 16 + fr) * CP + (ds * 32 + fq * 8) * 2);
                            f32x4 a = (f32x4){0.f, 0.f, 0.f, 0.f};
#pragma unroll
                            for (int ds = 0; ds < 4; ++ds) a = __builtin_amdgcn_mfma_f32_16x16x32_bf16(kf[ds], qf[ds], a, 0, 0, 0);
                            S[i] = a; }
                        float mx = -1e30f;
#pragma unroll
                        for (int i = 0; i < 8; ++i)
#pragma unroll
                            for (int jj = 0; jj < 4; ++jj) { const float sv = ((vm >> (i * 4 + jj)) & 1u) ? S[i][jj] : -1e30f; S[i][jj] = sv; mx = fmaxf(mx, sv); }
                        mx = fmaxf(mx, shx(mx, 16, ln_)); mx = fmaxf(mx, shx(mx, 32, ln_));
                        float psum = 0.f;
#pragma unroll
                        for (int i = 0; i < 8; ++i)
#pragma unroll
                            for (int jj = 0; jj < 4; ++jj) { const float pv = ((vm >> (i * 4 + jj)) & 1u) ? __builtin_amdgcn_exp2f(S[i][jj] - mx) : 0.f; S[i][jj] = pv; psum += pv; }
                        psum += shx(psum, 16, ln_); psum += shx(psum, 32, ln_);
                        const float inv = psum > 0.f ? 1.0f / psum : 0.f;
#pragma unroll
                        for (int i = 0; i < 8; ++i) { S[i] *= inv; pall[i] += S[i]; }
                        bf16x8 pb[4];
#pragma unroll
                        for (int pp = 0; pp < 4; ++pp) { u32x4 w; w.x = pk2(S[2 * pp][0], S[2 * pp][1]); w.y = pk2(S[2 * pp][2], S[2 * pp][3]); w.z = pk2(S[2 * pp + 1][0], S[2 * pp + 1][1]); w.w = pk2(S[2 * pp + 1][2], S[2 * pp + 1][3]);
                            pb[pp] = __builtin_bit_cast(bf16x8, w); }
                        const float gate = CG[trow * 18 + (3 * hkv + g) * 3 + 0];
#pragma unroll
                        for (int dt = 0; dt < 8; ++dt) { f32x4 o = (f32x4){0.f, 0.f, 0.f, 0.f};
#pragma unroll
                            for (int pp = 0; pp < 4; ++pp) { const LAS unsigned char* vp = vt2 + (32 * pp + 4 * fq + (fr >> 2)) * 288 + (dt * 16 + 4 * (fr & 3)) * 2;
                                const tr4_t lo = __builtin_amdgcn_ds_read_tr16_b64_v4i16((LAS tr4_t*)vp), hi = __builtin_amdgcn_ds_read_tr16_b64_v4i16((LAS tr4_t*)(vp + 16 * 288));
                                o = __builtin_amdgcn_mfma_f32_16x16x32_bf16((bf16x8){lo[0], lo[1], lo[2], lo[3], hi[0], hi[1], hi[2], hi[3]}, pb[pp], o, 0, 0, 0); }
                            o *= gate; u32x2 w; w.x = pk2(o[0], o[1]); w.y = pk2(o[2], o[3]);
                            *(u32x2*)(OC + trow * DATT + (3 * hkv + g) * 128 + dt * 16 + 4 * fq) = w; }
                        asm volatile("" ::: "memory");
                    }
                    float imp[8];
#pragma unroll
                    for (int i = 0; i < 8; ++i) { const float own = (pall[i][0] + pall[i][1]) + (pall[i][2] + pall[i][3]); const float v3 = pall[i][3]; const float prev3 = (i > 0) ? pall[i > 0 ? i - 1 : 0][3] : 0.f;
                        const float a = shidx(v3, (ln_ + 48) & 63), c = shidx(prev3, (ln_ + 48) & 63); imp[i] = own + (fq > 0 ? a : c); }
                    const int cur = (cb * 128 + wid * 16) >> 6; unsigned mask;
                    if (cur < 16) mask = (2u << cur) - 1u;
                    else { int rank[8] = {0, 0, 0, 0, 0, 0, 0, 0};
#pragma unroll
                        for (int i2 = 0; i2 < 8; ++i2)
#pragma unroll
                            for (int f2 = 0; f2 < 4; ++f2) { const float o = shidx(imp[i2], fr + 16 * f2); const int m2 = 4 * i2 + f2;
                                if (m2 >= 1 && m2 <= cur - 2) {
#pragma unroll
                                    for (int i = 0; i < 8; ++i) { const int m = 4 * i + fq; rank[i] += (o > imp[i] || (o == imp[i] && m2 < m)) ? 1 : 0; } } }
                        unsigned bits = 0u;
#pragma unroll
                        for (int i = 0; i < 8; ++i) { const int m = 4 * i + fq; if (m >= 1 && m <= cur - 2 && rank[i] < 13) bits |= 1u << m; }
                        bits |= shx(bits, 16, ln_); bits |= shx(bits, 32, ln_);
                        mask = bits | 1u | (1u << cur) | (1u << (cur - 1)); }
                    if (fq == 0) SEL[(size_t)(b * 2 + hkv) * SEQ + tq] = mask;
                }
                __syncthreads();
                int ln_ = fresh_tid(wid0) & 63; const int fr = ln_ & 15, fq = ln_ >> 4;
                const int tq = cb * 128 + wid * 16 + fr, tq_lo = cb * 128 + wid * 16, tq_hi = tq_lo + 15;
                const size_t trow_u = (size_t)b * SEQ + tq_lo;
                { const bf16_t* qu = QR + trow_u * DATT + (3 * hkv) * 128; const unsigned qo = (unsigned)fr * DATT + fq * 8;
#pragma unroll
                for (int g = 0; g < 3; ++g)
#pragma unroll
                    for (int ds = 0; ds < 4; ++ds) { const u32x4 v = *(const u32x4*)(qu + qo + g * 128 + ds * 32); *(LAS u32x4*)(qw + (g * 16 + fr) * KS_PITCH + (ds * 32 + fq * 8) * 2) = v; } }
                const unsigned selm = (SEL + (size_t)(b * 2 + hkv) * SEQ + tq_lo)[fr];
                for (int br = 0; br < 2; ++br) {
                    const bf16_t* Kb = (br == 0 ? KSLC : KWIN) + ((size_t)hkv * T_ + (size_t)b * SEQ) * 128;
                    const bf16_t* Vb = (br == 0 ? VSLC : VWIN) + ((size_t)hkv * T_ + (size_t)b * SEQ) * 128;
                    const int j1 = 2 * cb + 1, j0 = (br == 0) ? 0 : (2 * cb - 8 > 0 ? 2 * cb - 8 : 0);
                    f32x4 O[3][8];
#pragma unroll
                    for (int g = 0; g < 3; ++g)
#pragma unroll
                        for (int dt = 0; dt < 8; ++dt) O[g][dt] = (f32x4){0.f, 0.f, 0.f, 0.f};
                    float mrun[3] = {-1e30f, -1e30f, -1e30f}, lrun[3] = {0.f, 0.f, 0.f};
                    u32x4 kreg[2], vreg[2];
#define ATT_LOAD(j) do { const bf16_t* kt_ = Kb + (size_t)(j) * 64 * 128; const bf16_t* vtl_ = Vb + (size_t)(j) * 64 * 128; \
                        _Pragma("unroll") for (int i_ = 0; i_ < 2; ++i_) { kreg[i_] = *(const u32x4*)(kt_ + ((unsigned)tid * 8u + 4096u * i_)); \
                        vreg[i_] = *(const u32x4*)(vtl_ + ((unsigned)tid * 8u + 4096u * i_)); } } while (0)
#define ATT_STORE() do { _Pragma("unroll") for (int i_ = 0; i_ < 2; ++i_) { const int c_ = tid + 512 * i_; *(LAS u32x4*)(ks + (c_ >> 4) * KS_PITCH + (c_ & 15) * 16) = kreg[i_]; \
                            *(LAS u32x4*)(vt + (c_ >> 4) * VT_PITCH + (c_ & 15) * 16) = vreg[i_]; } } while (0)
                    ATT_LOAD(j0);
                    for (int j = j0; j <= j1; ++j) {
                        __syncthreads();
                        ATT_STORE();
                        __syncthreads();
                        if (j < j1) ATT_LOAD(j + 1);
                        bool active = (j * 64 <= tq_hi);
                        if (br == 1) active = active && (j * 64 + 63 > tq_lo - 512);
                        if (br == 0) active = active && (__ballot((selm >> j) & 1u) != 0ull);
                        if (active) {
                            unsigned vm = 0u;
#pragma unroll
                            for (int kq = 0; kq < 4; ++kq)
#pragma unroll
                                for (int jj = 0; jj < 4; ++jj) { const int kk = j * 64 + kq * 16 + 4 * fq + jj; bool ok = kk <= tq; if (br == 1) ok = ok && (kk > tq - 512); else ok = ok && ((selm >> j) & 1u); vm |= (ok ? 1u : 0u) << (kq * 4 + jj); }
                            bf16x8 pb[3][2];
#pragma unroll
                            for (int g = 0; g < 3; ++g) {
                                bf16x8 qf[4];
#pragma unroll
                                for (int ds = 0; ds < 4; ++ds) qf[ds] = *(const LAS bf16x8*)(qw + (g * 16 + fr) * KS_PITCH + (ds * 32 + fq * 8) * 2);
                                f32x4 S[4];
#pragma unroll
                                for (int kq = 0; kq < 4; ++kq) { bf16x8 kf[4];
#pragma unroll
                                    for (int ds = 0; ds < 4; ++ds) kf[ds] = *(const LAS bf16x8*)(ks + (kq * 16 + fr) * KS_PITCH + (ds * 32 + fq * 8) * 2);
                                    f32x4 a = (f32x4){0.f, 0.f, 0.f, 0.f};
#pragma unroll
                                    for (int ds = 0; ds < 4; ++ds) a = __builtin_amdgcn_mfma_f32_16x16x32_bf16(kf[ds], qf[ds], a, 0, 0, 0);
                                    S[kq] = a; }
                                float mx = -1e30f;
#pragma unroll
                                for (int kq = 0; kq < 4; ++kq)
#pragma unroll
                                    for (int jj = 0; jj < 4; ++jj) { const float sv = ((vm >> (kq * 4 + jj)) & 1u) ? S[kq][jj] : -1e30f; S[kq][jj] = sv; mx = fmaxf(mx, sv); }
                                mx = fmaxf(mx, shx(mx, 16, ln_)); mx = fmaxf(mx, shx(mx, 32, ln_));
                                if (__builtin_amdgcn_ballot_w64(mx > mrun[g] + 8.0f) != 0ull) {
                                    const float mnew_ = fmaxf(mrun[g], mx), alpha = __builtin_amdgcn_exp2f(mrun[g] - mnew_); mrun[g] = mnew_; lrun[g] *= alpha;
#pragma unroll
                                    for (int dt = 0; dt < 8; ++dt) O[g][dt] *= alpha; }
                                const float mnew = mrun[g];
                                float psum = 0.f;
#pragma unroll
                                for (int kq = 0; kq < 4; ++kq)
#pragma unroll
                                    for (int jj = 0; jj < 4; ++jj) { const float pv = ((vm >> (kq * 4 + jj)) & 1u) ? __builtin_amdgcn_exp2f(S[kq][jj] - mnew) : 0.f; S[kq][jj] = pv; psum += pv; }
                                lrun[g] += psum;
#pragma unroll
                                for (int pp = 0; pp < 2; ++pp) { u32x4 w; w.x = pk2(S[2 * pp][0], S[2 * pp][1]); w.y = pk2(S[2 * pp][2], S[2 * pp][3]); w.z = pk2(S[2 * pp + 1][0], S[2 * pp + 1][1]); w.w = pk2(S[2 * pp + 1][2], S[2 * pp + 1][3]);
                                    pb[g][pp] = __builtin_bit_cast(bf16x8, w); }
                                asm volatile("" ::: "memory");
                            }
#pragma unroll
                            for (int pp = 0; pp < 2; ++pp)
#pragma unroll
                                for (int dt = 0; dt < 8; ++dt) { const LAS unsigned char* vp = vt + (32 * pp + 4 * fq + (fr >> 2)) * VT_PITCH + (dt * 16 + 4 * (fr & 3)) * 2;
                                    const tr4_t lo = __builtin_amdgcn_ds_read_tr16_b64_v4i16((LAS tr4_t*)vp), hi = __builtin_amdgcn_ds_read_tr16_b64_v4i16((LAS tr4_t*)(vp + 16 * VT_PITCH));
                                    const bf16x8 vf = (bf16x8){lo[0], lo[1], lo[2], lo[3], hi[0], hi[1], hi[2], hi[3]};
#pragma unroll
                                    for (int g = 0; g < 3; ++g) O[g][dt] = __builtin_amdgcn_mfma_f32_16x16x32_bf16(vf, pb[g][pp], O[g][dt], 0, 0, 0);
                                    if ((dt & 3) == 3) asm volatile("" ::: "memory"); }
                        }
                    }
#undef ATT_LOAD
#undef ATT_STORE
                    { const float* cgu = CG + trow_u * 18 + (3 * hkv) * 3 + 1 + br; const unsigned lo768 = (unsigned)fr * DATT + 4 * fq, lo2048 = (unsigned)fr * DM + 4 * fq;
                      const bf16_t* ocu = OC + trow_u * DATT + (3 * hkv) * 128; bf16_t* acu = ACT + trow_u * DM + DCONV + DRNN + (3 * hkv) * 128;
#pragma unroll
                    for (int g = 0; g < 3; ++g) { float lt = lrun[g]; lt += shx(lt, 16, ln_); lt += shx(lt, 32, ln_);
                        const float gate = cgu[(unsigned)fr * 18 + g * 3]; const float sc = gate / lt;
#pragma unroll
                        for (int dt = 0; dt < 8; ++dt) { f32x4 r = O[g][dt] * sc;
                            if (br == 0) { const u32x2 pw = *(const u32x2*)(ocu + lo768 + g * 128 + dt * 16); r[0] += bflo(pw.x); r[1] += bfhi(pw.x); r[2] += bflo(pw.y); r[3] += bfhi(pw.y); }
                            else { const u32x2 pw = *(const u32x2*)(acu + lo2048 + g * 128 + dt * 16); r[0] += bflo(pw.x); r[1] += bfhi(pw.x); r[2] += bflo(pw.y); r[3] += bfhi(pw.y); }
                            u32x2 w; w.x = pk2(r[0], r[1]); w.y = pk2(r[2], r[3]); *(u32x2*)(acu + lo2048 + g * 128 + dt * 16) = w;
                            asm volatile("" ::: "memory"); } } }
                }
                __syncthreads();
            }
            {
                int tidf = tid; asm volatile("" : "+v"(tidf)); const int lanef = tidf & 63;
                const auto ABUF_f = P_ABUF;
                const auto BBUF_f = P_BBUF;
                const auto ACT_f = P_ACT;
                const auto GG_f = P_GG;
                const auto UB_f = P_UB;
                const auto conv_dw_w_f = P_conv_dw_w;
                const auto conv_dw_b_f = P_conv_dw_b;
                const auto conv_ln_g_f = P_conv_ln_g;
                const auto conv_ln_b_f = P_conv_ln_b;
                unsigned* qctr = (unsigned*)ws_at(p, WS_CTL + CTL_BAR + 14336) + l;
                LAS int* wslot = (LAS int*)(lds + LDS_BYTES - 32);
                for (;;) {
                    __syncthreads();
                    if (tidf == 0) *wslot = (int)__hip_atomic_fetch_add(qctr, 1u, __ATOMIC_RELAXED, __HIP_MEMORY_SCOPE_AGENT);
                    __syncthreads();
                    const int wk = __builtin_amdgcn_readfirstlane(*wslot);
                    if (wk >= 384 + 512) break;
                    int tw_ = tidf; asm volatile("" : "+v"(tw_)); const int ck = tw_ >> 4, j = tw_ & 15, lanew = tw_ & 63;
                    if (wk < 384) {
                        LAS float* Ps = (LAS float*)lds; LAS float* Hs = Ps + 512;
                        const int unit = wk; const int b = unit / (DRNN / 16), ch = (unit % (DRNN / 16)) * 16 + j;
                        const float* ab_u = ABUF_f + (size_t)b * SEQ * DRNN; const float* bb_u = BBUF_f + (size_t)b * SEQ * DRNN;
                        const unsigned voff = (unsigned)(ck * 64) * DRNN + ch;
                        float av[64], bv[64];
#pragma unroll
                        for (int s2 = 0; s2 < 64; ++s2) { av[s2] = (ab_u + (size_t)s2 * DRNN)[voff]; bv[s2] = (bb_u + (size_t)s2 * DRNN)[voff]; }
                        float P = 1.f, H = 0.f;
#pragma unroll
                        for (int s2 = 0; s2 < 64; ++s2) { P *= av[s2]; H = av[s2] * H + bv[s2]; }
                        Ps[tw_] = P; Hs[tw_] = H; __syncthreads();
                        float h = 0.f; for (int c2 = 0; c2 < ck; ++c2) h = Ps[c2 * 16 + j] * h + Hs[c2 * 16 + j];
                        const bf16_t* gg_u = GG_f + (size_t)b * SEQ * DRNN; bf16_t* act_u = ACT_f + (size_t)b * SEQ * DM + DCONV; const unsigned aoff = (unsigned)(ck * 64) * DM + ch;
#pragma unroll
                        for (int s2 = 0; s2 < 64; ++s2) { h = av[s2] * h + bv[s2];
                            (act_u + (size_t)s2 * DM)[aoff] = (bf16_t)f2bf(h * bf2f((gg_u + (size_t)s2 * DRNN)[voff])); }
                    } else {
                        LAS float* ct = (LAS float*)lds;
                        const int c = tw_, unit = wk - 384;
                        const int t0 = unit * 32, pos0 = t0 & (SEQ - 1);
                        float w[31];
#pragma unroll
                        for (int jj = 0; jj < 31; ++jj) w[jj] = (conv_dw_w_f + jj * DCONV)[(unsigned)c];
                        const float bias = conv_dw_b_f[c];
                        float acc[32];
#pragma unroll
                        for (int tt = 0; tt < 32; ++tt) acc[tt] = bias;
                        unsigned ccv = (unsigned)c;
#pragma unroll
                        for (int s2 = 0; s2 < 62; ++s2) {
                            const int pr = pos0 - 30 + s2;
                            if ((s2 & 7) == 0) asm volatile("" : "+v"(ccv)); float v = 0.f; if (pr >= 0) v = bf2f((UB_f + (size_t)(t0 - 30 + s2) * DCONV)[ccv]);
#pragma unroll
                            for (int tt = 0; tt < 32; ++tt) { const int jj = s2 - tt; if (jj >= 0 && jj <= 30) acc[tt] += w[jj] * v; }
                            if ((s2 & 7) == 7) asm volatile("" ::: "memory");
                        }
#pragma unroll
                        for (int tt = 0; tt < 32; ++tt) ct[tt * 512 + c] = acc[tt];
                        __syncthreads();
#pragma unroll
                        for (int q = 0; q < 4; ++q) { const int tt = wid * 4 + q; float v[8]; float sm = 0.f;
#pragma unroll
                            for (int i = 0; i < 8; ++i) { v[i] = ct[tt * 512 + lanew + 64 * i]; sm += v[i]; }
                            const float mu = wave_sum(sm, lanew) * (1.f / 512.f); float s2 = 0.f;
#pragma unroll
                            for (int i = 0; i < 8; ++i) { v[i] -= mu; s2 += v[i] * v[i]; }
                            const float rstd = rsqrtf(wave_sum(s2, lanew) * (1.f / 512.f) + NORM_EPS);
#pragma unroll
                            for (int i = 0; i < 8; ++i) { const int ch = lanew + 64 * i; const float y = v[i] * rstd * conv_ln_g_f[ch] + conv_ln_b_f[ch]; (ACT_f + (size_t)(t0 + tt) * DM)[(unsigned)ch] = (bf16_t)f2bf(y * sigmoidf_(y)); }
                        }
                    }
                }
            }
        }
        PH_END

        PH_BEGIN(6)
        const auto WCO = P_WCO;
        const auto WRO = P_WRO;
        const auto WAO = P_WAO;
        const auto ACT = P_ACT;
        const auto YB = P_YB;
        const auto GATES = P_GATES;
        {
            { pg8::StdSched S; S.init(ACT, DM, WCO, DCONV, T_, DM, G, bid); EpiMerge<true> E{YB, GATES}; pg8::gemm_phase(lds, tid, DCONV, DM, DCONV, S, E); }
            { pg8::StdSched S; S.init(ACT + DCONV, DM, WRO, DRNN, T_, DM, G, bid); EpiMerge<false> E{YB, GATES + (size_t)T_ * DM}; pg8::gemm_phase(lds, tid, DRNN, DM, DRNN, S, E); }
            { pg8::StdSched S; S.init(ACT + DCONV + DRNN, DM, WAO, DATT, T_, DM, G, bid); EpiMerge<false> E{YB, GATES + (size_t)2 * T_ * DM}; pg8::gemm_phase(lds, tid, DATT, DM, DATT, S, E); }
        }
        PH_END

        PH_BEGIN(7)
        const auto WO = P_WO;
        const auto ACT = P_ACT;
        const auto YB = P_YB;
        const auto xin = P_xin;
        { pg8::StdSched S; S.init(YB, DM, WO, DM, T_, DM, G, bid); EpiResid E{xin, X, ACT, P_RSS + (size_t)(2 * l) * T_}; pg8::gemm_phase(lds, tid, DM, DM, DM, S, E); }
        PH_END

        PH_BEGIN(9)
        const auto WUP = P_WUP;
        const auto ACT = P_ACT;
        const auto HID = P_HID;
        { pg8::StdSched S; S.init(ACT, DM, WUP, DM, T_, DFF, G, bid); EpiRelu2 E{HID, P_RSS + (size_t)(2 * l) * T_}; pg8::gemm_phase(lds, tid, DM, DM, DM, S, E); }
        PH_END

        PH_BEGIN(10)
        const auto WDN = P_WDN;
        const auto HID = P_HID;
        { pg8::StdSched S; S.init(HID, DFF, WDN, DFF, T_, DM, G, bid); EpiResid E{X, X, (l + 1 < NLAYER) ? (bf16_t*)P_ACT : (bf16_t*)nullptr, P_RSS + (size_t)(2 * l + 1) * T_}; pg8::gemm_phase(lds, tid, DFF, DFF, DFF, S, E); }
        PH_END
    }

    PH_BEGIN(11)
    {
        const float* fg = in_at(p, 26, 0);
        for (int m = gw; m < T_; m += NGW) { f32x4* xr = (f32x4*)(X + (size_t)m * DM) + lane; f32x4 v[8]; float s = 0.f;
#pragma unroll
            for (int j = 0; j < 8; ++j) { v[j] = xr[64 * j]; s += (v[j].x * v[j].x + v[j].y * v[j].y) + (v[j].z * v[j].z + v[j].w * v[j].w); }
            const float rstd = rsqrtf(wave_sum(s, lane) * (1.f / DM) + NORM_EPS);
#pragma unroll
            for (int j = 0; j < 8; ++j) { const f32x4 g = *((const f32x4*)fg + lane + 64 * j); xr[64 * j] = v[j] * rstd * g; }
        }
    }
    PH_END
#undef PH_BEGIN
#undef PH_END
}

constexpr int N_PHASES = NLAYER * 9 + 1;

extern "C" void kernel_launch(void* const* d_in, const int* in_sizes, int n_in, void* d_out, int out_size, void* d_ws, size_t ws_size, hipStream_t stream) {
    static int grid = 0;
    if (grid == 0) {
        if (n_in != 27 || ws_size < WS_END) { fprintf(stderr, "kernel_launch: unexpected n_in %d or ws_size %zu (need %zu)\n", n_in, ws_size, (size_t)WS_END); }
        int dev = 0, cus = 0, per_cu = 0;
        hipGetDevice(&dev); hipDeviceGetAttribute(&cus, hipDeviceAttributeMultiprocessorCount, dev);
        hipFuncSetAttribute((const void*)fwd_kernel, hipFuncAttributeMaxDynamicSharedMemorySize, LDS_BYTES);
        hipOccupancyMaxActiveBlocksPerMultiprocessor(&per_cu, (const void*)fwd_kernel, 512, LDS_BYTES);
        if (per_cu < 1) per_cu = 1;
        grid = cus * per_cu;
        (void)hipGetLastError();
    }
    Params p{};
    for (int i = 0; i < 27; ++i) p.in[i] = (const float*)d_in[i];
    p.out = (float*)d_out; p.ws = (unsigned char*)d_ws; p.ph_lo = 0; p.ph_hi = N_PHASES;
    (void)hipMemsetAsync((unsigned char*)d_ws + WS_CTL + CTL_BAR, 0, CTL_ZERO_BYTES, stream);
    void* args[] = {&p};
    hipError_t e = hipLaunchCooperativeKernel((const void*)fwd_kernel, dim3(grid), dim3(512), args, LDS_BYTES, stream);
    if (e != hipSuccess) fprintf(stderr, "cooperative launch failed: %s (grid %d)\n", hipGetErrorString(e), grid);
#ifdef PROBE_LIST
    { const int probe[] = {PROBE_LIST};
      for (unsigned i = 0; i < sizeof(probe) / sizeof(int); ++i) { p.ph_lo = probe[i]; p.ph_hi = probe[i] + 1; p.flags = PROBE_FLAGS; void* a2[] = {&p};
          hipLaunchCooperativeKernel((const void*)fwd_kernel, dim3(grid), dim3(512), a2, LDS_BYTES, stream); } }
#endif
}
```

```cpp
#include <hip/hip_runtime.h>
#include <hip/hip_cooperative_groups.h>
#include <cstdio>
#include <cstdint>

namespace cg = cooperative_groups;

#define LAS __attribute__((address_space(3)))
typedef unsigned short bf16_t;
typedef short bf16x8 __attribute__((ext_vector_type(8)));
typedef float f32x4 __attribute__((ext_vector_type(4)));
typedef float f32x2 __attribute__((ext_vector_type(2)));
typedef unsigned u32x4 __attribute__((ext_vector_type(4)));
typedef unsigned u32x2 __attribute__((ext_vector_type(2)));
typedef short tr4_t __attribute__((ext_vector_type(4)));

constexpr int T_ = 16384, DM = 2048, SEQ = 2048, NBATCH = 8, NLAYER = 2;
constexpr int NIN = 11026, NINP = 11264;
constexpr int DCONV = 512, DRNN = 768, DATT = 768, DFF = 8192;
constexpr int KVROWS = T_ + 64;
constexpr float C2 = 0.08838834764831845f * 1.4426950408889634f;
constexpr float NORM_EPS = 1e-6f;

constexpr size_t MiB = 1u << 20;
constexpr size_t WS_CTL = 0, WS_ROPE = 1 * MiB, WS_WIN = 2 * MiB, WS_WCO = 46 * MiB, WS_WRO = 48 * MiB, WS_WAO = 51 * MiB, WS_WO = 54 * MiB,
                 WS_WUP = 62 * MiB, WS_WDN = 94 * MiB, WS_WG = 126 * MiB, WS_W1K = 127 * MiB, WS_W1V = 129 * MiB,
                 WS_ACT = 131 * MiB, WS_H = 195 * MiB, WS_R1 = 259 * MiB, WS_XC = 307 * MiB, WS_GG = 331 * MiB, WS_Q = 355 * MiB, WS_QR = 379 * MiB,
                 WS_KCMP = 403 * MiB, WS_VCMP = 412 * MiB, WS_KSLC = 421 * MiB, WS_VSLC = 429 * MiB, WS_KWIN = 437 * MiB, WS_VWIN = 445 * MiB,
                 WS_CG = 453 * MiB, WS_GATES = 455 * MiB, WS_PART = 647 * MiB, WS_KC = 663 * MiB, WS_VC = 664 * MiB, WS_SEL = 665 * MiB, WS_U = 666 * MiB, WS_END = 682 * MiB;
constexpr size_t CTL_BPART = 65536, CTL_SPC = 131072, CTL_BAR = 262144, CTL_BAR_BYTES = 16384, CTL_RSS = 524288, CTL_ZERO_BYTES = 524288;

constexpr int LDS_BYTES = 147456;

__device__ __forceinline__ unsigned f2bf(float f) { unsigned u = __builtin_bit_cast(unsigned, f); return (u + 0x7fffu + ((u >> 16) & 1u)) >> 16; }
typedef __bf16 hwbf16x2 __attribute__((ext_vector_type(2)));
__device__ __forceinline__ unsigned pk2(float lo, float hi) { const f32x2 v = {lo, hi}; const hwbf16x2 b = __builtin_convertvector(v, hwbf16x2); return __builtin_bit_cast(unsigned, b); }
__device__ __forceinline__ float bf2f(unsigned b) { return __builtin_bit_cast(float, b << 16); }
__device__ __forceinline__ float bflo(unsigned w) { return __builtin_bit_cast(float, w << 16); }
__device__ __forceinline__ float bfhi(unsigned w) { return __builtin_bit_cast(float, w & 0xffff0000u); }
__device__ __forceinline__ float sigmoidf_(float x) { return __builtin_amdgcn_rcpf(1.0f + __expf(-x)); }
__device__ __forceinline__ float gelu_tanh(float x) { const float y = 1.5957691216057308f * (x + 0.044715f * x * x * x); return x * sigmoidf_(y); }
__device__ __forceinline__ float shx(float v, int mask, int lane) { return __builtin_bit_cast(float, __builtin_amdgcn_ds_bpermute((lane ^ mask) << 2, __builtin_bit_cast(int, v))); }
__device__ __forceinline__ unsigned shx(unsigned v, int mask, int lane) { return (unsigned)__builtin_amdgcn_ds_bpermute((lane ^ mask) << 2, (int)v); }
__device__ __forceinline__ float shidx(float v, int src) { return __builtin_bit_cast(float, __builtin_amdgcn_ds_bpermute(src << 2, __builtin_bit_cast(int, v))); }
__device__ __forceinline__ float wave_sum(float v, int lane) {
#pragma unroll
    for (int o = 1; o < 64; o <<= 1) v += shx(v, o, lane);
    return v;
}
__device__ __forceinline__ float wave_max(float v, int lane) {
#pragma unroll
    for (int o = 1; o < 64; o <<= 1) v = fmaxf(v, shx(v, o, lane));
    return v;
}
__device__ __forceinline__ float wave_sum_OLD(float v) {
#pragma unroll
    for (int o = 1; o < 64; o <<= 1) v += __shfl_xor(v, o);
    return v;
}
__device__ __forceinline__ float wave_max(float v) {
#pragma unroll
    for (int o = 1; o < 64; o <<= 1) v = fmaxf(v, __shfl_xor(v, o));
    return v;
}
#define LDS_WAIT() asm volatile("s_waitcnt lgkmcnt(0)" ::: "memory")

namespace pg8 {
constexpr int BM = 256, BK = 64, HALF = 128, HTB = HALF * BK * 2, STAGE_BYTES = 8 * HTB, NXCD = 8, WGM = 8;
__device__ __forceinline__ int lds_byte(int r, int c) { const int st = (r >> 4) * 2 + (c >> 5), rr = r & 15, cc = c & 31, ob = rr * 64 + cc * 2; return st * 1024 + (ob ^ (((ob >> 9) & 1) << 5)); }
__device__ __forceinline__ void stage_rc(int b, int& R, int& C) { const int st = b / 1024, sb = b % 1024, swz = sb ^ (((sb >> 9) & 1) << 5); R = (st >> 1) * 16 + swz / 64; C = (st & 1) * 32 + (swz % 64) / 2; }
__device__ __forceinline__ int perm32(int rho) { const int n = rho >> 4, i = rho & 15; return 8 * (i >> 2) + 4 * n + (i & 3); }

struct Unit { int pm, pn; const char* a; const char* b; };

struct StdSched {
    const char* A; const char* B; size_t a_tile, b_tile; int nM, nN, nwg, G, c;
    __device__ void init(const void* A_, int lda, const void* B_, int ldb, int M, int N, int G_, int c_) {
        A = (const char*)A_; B = (const char*)B_; a_tile = (size_t)BM * lda * 2; b_tile = (size_t)BM * ldb * 2; nM = M / BM; nN = N / BM; nwg = nM * nN; G = G_; c = c_; }
    __device__ bool next(int i, Unit& u) const {
        const long L = (long)i * G + c; if (L >= nwg) return false;
        int wgid = (int)L; { const int q = nwg / NXCD, r = nwg % NXCD, xcd = wgid % NXCD, off = wgid / NXCD; wgid = (xcd < r ? xcd * (q + 1) : r * (q + 1) + (xcd - r) * q) + off; }
        const int nig = WGM * nN, gid = wgid / nig, fm = gid * WGM, gsz = (nM - fm) < WGM ? (nM - fm) : WGM;
        u.pm = fm + ((wgid % nig) % gsz); u.pn = (wgid % nig) / gsz; u.a = A + (size_t)u.pm * a_tile; u.b = B + (size_t)u.pn * b_tile; return true;
    }
};

template <class Epi, class Sched>
__device__ __forceinline__ void gemm_phase(LAS unsigned char* lds, const int tid, const int K, const int lda, const int ldb, const Sched& S, const Epi& E) {
    const int wid = __builtin_amdgcn_readfirstlane(tid >> 6), lane = tid & 63, wr = wid >> 2, wc = wid & 3, fr = lane & 15, fq = lane >> 4;
    const int nt = K / BK;
    unsigned voffA[2], voffB[2];
#pragma unroll
    for (int i = 0; i < 2; ++i) { int R, C; stage_rc(tid * 16 + i * 8192, R, C); const int Rb = Epi::PERM ? ((R & ~31) + perm32(R & 31)) : R;
        voffA[i] = (unsigned)(R * lda + C) * 2u; voffB[i] = (unsigned)(Rb * ldb + C) * 2u; }
    const size_t kstep = (size_t)(BK * 2);
    const size_t hstepA = (size_t)HALF * lda * 2, hstepB = (size_t)HALF * ldb * 2;
    const unsigned ldsw = (unsigned)wid * 1024u;
    const int aoff = lds_byte(wr * 64 + fr, fq * 8), boff = lds_byte(wc * 32 + fr, fq * 8);
#define PG8_SA(b, h) (((b) * 2 + (h)) * HTB)
#define PG8_SB(b, h) ((4 + (b) * 2 + (h)) * HTB)
#define PG8_STAGE(bufoff, gbase, voff) do { _Pragma("unroll") for (int _i = 0; _i < 2; ++_i) \
        __builtin_amdgcn_global_load_lds((const unsigned*)((const char*)(gbase) + (voff)[_i]), (LAS unsigned*)(lds + (bufoff) + ldsw + _i * 8192), 16, 0, 0); } while (0)
#define PG8_LDA(dst, b, h) do { _Pragma("unroll") for (int m = 0; m < 4; ++m) _Pragma("unroll") for (int k = 0; k < 2; ++k) dst[m][k] = *(const LAS bf16x8*)(lds + PG8_SA(b, h) + aoff + m * 2048 + k * 1024); } while (0)
#define PG8_LDB(dst, b, h) do { _Pragma("unroll") for (int n = 0; n < 2; ++n) _Pragma("unroll") for (int k = 0; k < 2; ++k) dst[n][k] = *(const LAS bf16x8*)(lds + PG8_SB(b, h) + boff + n * 2048 + k * 1024); } while (0)
#define PG8_MMA(ai, bj, At, Bt) do { __builtin_amdgcn_s_setprio(1); _Pragma("unroll") for (int m = 0; m < 4; ++m) _Pragma("unroll") for (int n = 0; n < 2; ++n) _Pragma("unroll") for (int k = 0; k < 2; ++k) \
        acc[ai][bj][m][n] = __builtin_amdgcn_mfma_f32_16x16x32_bf16(Bt[n][k], At[m][k], acc[ai][bj][m][n], 0, 0, 0); __builtin_amdgcn_s_setprio(0); } while (0)
#define PG8_WAIT_V(n) asm volatile("s_waitcnt vmcnt(" #n ")" ::: "memory")
#define PG8_WAIT_L(n) asm volatile("s_waitcnt lgkmcnt(" #n ")" ::: "memory")
#define PG8_BAR __builtin_amdgcn_s_barrier()
#define PG8_SCHED __builtin_amdgcn_sched_barrier(0)
    Unit cur, nxt; int ui = 0;
    if (!S.next(0, cur)) return;
    f32x4 acc[2][2][4][2];
#pragma unroll
    for (int a = 0; a < 2; ++a)
#pragma unroll
        for (int b = 0; b < 2; ++b)
#pragma unroll
            for (int m = 0; m < 4; ++m)
#pragma unroll
                for (int n = 0; n < 2; ++n) acc[a][b][m][n] = (f32x4){0.f, 0.f, 0.f, 0.f};
    bf16x8 At[4][2], B0[2][2], B1[2][2];
    const char* cA = cur.a; const char* cB = cur.b;
    PG8_STAGE(PG8_SB(0, 0), cB, voffB); PG8_STAGE(PG8_SB(0, 1), cB + hstepB, voffB); PG8_STAGE(PG8_SA(0, 0), cA, voffA); PG8_STAGE(PG8_SA(0, 1), cA + hstepA, voffA);
    if (wr == 1) PG8_BAR;
    PG8_WAIT_V(2); PG8_BAR;
    PG8_STAGE(PG8_SB(1, 0), cB + kstep, voffB); PG8_STAGE(PG8_SA(1, 0), cA + kstep, voffA); PG8_STAGE(PG8_SB(1, 1), cB + hstepB + kstep, voffB);
    PG8_WAIT_V(6); PG8_BAR;
    for (;;) {
        const bool has_next = S.next(ui + 1, nxt);
        const char* nA = has_next ? nxt.a : cA; const char* nB = has_next ? nxt.b : cB;
        for (int t = 0; t < nt; t += 2) {
            const bool last = (t == nt - 2);
            const char* a1 = cA + (size_t)(t + 1) * kstep;
            const char* a2 = last ? nA : cA + (size_t)(t + 2) * kstep; const char* b2 = last ? nB : cB + (size_t)(t + 2) * kstep;
            const char* a3 = a2 + kstep; const char* b3 = b2 + kstep;
            PG8_LDB(B0, 0, 0); PG8_LDB(B1, 0, 1); PG8_SCHED; PG8_LDA(At, 0, 0); PG8_STAGE(PG8_SA(1, 1), a1 + hstepA, voffA);
            PG8_WAIT_V(8); PG8_WAIT_L(0); PG8_BAR; PG8_MMA(0, 0, At, B0); PG8_MMA(0, 1, At, B1); PG8_BAR; PG8_SCHED;
            PG8_LDA(At, 0, 1); PG8_STAGE(PG8_SB(0, 0), b2, voffB); PG8_STAGE(PG8_SB(0, 1), b2 + hstepB, voffB); PG8_STAGE(PG8_SA(0, 0), a2, voffA);
            PG8_WAIT_V(8); PG8_WAIT_L(0); PG8_BAR; PG8_MMA(1, 0, At, B0); PG8_MMA(1, 1, At, B1); PG8_BAR; PG8_SCHED;
            PG8_LDB(B0, 1, 0); PG8_LDB(B1, 1, 1); PG8_SCHED; PG8_LDA(At, 1, 0); PG8_STAGE(PG8_SA(0, 1), a2 + hstepA, voffA);
            PG8_WAIT_V(8); PG8_WAIT_L(0); PG8_BAR; PG8_MMA(0, 0, At, B0); PG8_MMA(0, 1, At, B1); PG8_BAR; PG8_SCHED;
            PG8_LDA(At, 1, 1); PG8_STAGE(PG8_SB(1, 0), b3, voffB); PG8_STAGE(PG8_SB(1, 1), b3 + hstepB, voffB); PG8_STAGE(PG8_SA(1, 0), a3, voffA);
            PG8_WAIT_V(8); PG8_WAIT_L(0); PG8_BAR; PG8_MMA(1, 0, At, B0); PG8_MMA(1, 1, At, B1); PG8_BAR; PG8_SCHED;
        }
        if (wr == 0) PG8_BAR;
        E(acc, cur, wr, wc, fr, fq);
        if (!has_next) break;
#pragma unroll
        for (int a = 0; a < 2; ++a)
#pragma unroll
            for (int b = 0; b < 2; ++b)
#pragma unroll
                for (int m = 0; m < 4; ++m)
#pragma unroll
                    for (int n = 0; n < 2; ++n) acc[a][b][m][n] = (f32x4){0.f, 0.f, 0.f, 0.f};
        cur = nxt; cA = nA; cB = nB; ++ui;
        if (wr == 1) PG8_BAR;
    }
    PG8_WAIT_V(0);
    PG8_BAR;
#undef PG8_SA
#undef PG8_SB
#undef PG8_STAGE
#undef PG8_LDA
#undef PG8_LDB
#undef PG8_MMA
#undef PG8_WAIT_V
#undef PG8_WAIT_L
#undef PG8_BAR
#undef PG8_SCHED
}
}

typedef f32x4 AccT[2][2][4][2];

struct Params {
    const float* in[27];
    float* out; unsigned char* ws;
    int ph_lo, ph_hi, flags, pad1;
};

__device__ __forceinline__ u32x4 pack8(const f32x4 a, const f32x4 b) { u32x4 w; w.x = pk2(a[0], a[1]); w.y = pk2(a[2], a[3]); w.z = pk2(b[0], b[1]); w.w = pk2(b[2], b[3]); return w; }

#define EPI_ROWS_BEGIN _Pragma("unroll") for (int ai = 0; ai < 2; ++ai) _Pragma("unroll") for (int m = 0; m < 4; ++m) { int rowi = row0 + ai * 128 + m * 16; asm volatile("" : "+v"(rowi)); const size_t row = (size_t)rowi;
#define EPI_ROWS_END asm volatile("" ::: "memory"); }
#define EPI_RS const float rs_ = rss ? rsqrtf(rss[row] * (1.0f / DM) + NORM_EPS) : 1.0f;
struct EpiGLU {
    static constexpr bool PERM = true; bf16_t* U; const float* rss;
    __device__ __forceinline__ void operator()(const AccT& acc, const pg8::Unit& u, int wr, int wc, int fr, int fq) const {
        const int row0 = u.pm * 256 + wr * 64 + fr; bf16_t* d = U + u.pn * 128 + wc * 32 + 8 * fq;
        EPI_ROWS_BEGIN EPI_RS f32x4 o0, o1;
#pragma unroll
            for (int e = 0; e < 4; ++e) { o0[e] = (acc[ai][0][m][0][e] * rs_) * sigmoidf_(acc[ai][1][m][0][e] * rs_); o1[e] = (acc[ai][0][m][1][e] * rs_) * sigmoidf_(acc[ai][1][m][1][e] * rs_); }
            *(u32x4*)(d + row * DCONV) = pack8(o0, o1);
        EPI_ROWS_END
    }
};
struct EpiRnnIn {
    static constexpr bool PERM = true; bf16_t *RX, *GG; const float* rss;
    __device__ __forceinline__ void operator()(const AccT& acc, const pg8::Unit& u, int wr, int wc, int fr, int fq) const {
        const int row0 = u.pm * 256 + wr * 64 + fr; const bool isg = u.pn >= 3; bf16_t* d = (isg ? GG + (u.pn - 3) * 256 : RX + u.pn * 256) + wc * 32 + 8 * fq;
        EPI_ROWS_BEGIN EPI_RS
#pragma unroll
            for (int bj = 0; bj < 2; ++bj) { f32x4 o0 = acc[ai][bj][m][0] * rs_, o1 = acc[ai][bj][m][1] * rs_;
                if (isg) {
#pragma unroll
                    for (int e = 0; e < 4; ++e) { o0[e] = gelu_tanh(o0[e]); o1[e] = gelu_tanh(o1[e]); } }
                *(u32x4*)(d + row * DRNN + bj * 128) = pack8(o0, o1); }
        EPI_ROWS_END
    }
};
struct EpiRope {
    static constexpr bool PERM = true; bf16_t *Q, *QR, *KSLC, *KWIN; const f32x2* ROPE; const float* rss;
    __device__ __forceinline__ void operator()(const AccT& acc, const pg8::Unit& u, int wr, int wc, int fr, int fq) const {
        const int row0 = u.pm * 256 + wr * 64 + fr, cc = wc * 32 + 8 * fq, hh = cc >> 6, i0 = cc & 63; const bool isq = u.pn < 3;
        bf16_t* d0; bf16_t* dq = Q; int pitch; float sc;
        if (isq) { const int head = 2 * u.pn + hh; d0 = QR + head * 128 + i0; dq = Q + head * 128 + i0; pitch = DATT; sc = C2; }
        else { d0 = (u.pn == 3 ? KSLC : KWIN) + (size_t)hh * T_ * 128 + i0; pitch = 128; sc = 1.0f; }
        EPI_ROWS_BEGIN EPI_RS const float scr_ = sc * rs_; const f32x2* rp = ROPE + (rowi & (SEQ - 1)) * 64 + i0;
#pragma unroll
            for (int n = 0; n < 2; ++n) { const f32x4 x1 = acc[ai][0][m][n] * scr_, x2 = acc[ai][1][m][n] * scr_; f32x4 r1, r2;
#pragma unroll
                for (int e = 0; e < 4; ++e) { const f32x2 cs = rp[4 * n + e]; r1[e] = x1[e] * cs.x - x2[e] * cs.y; r2[e] = x2[e] * cs.x + x1[e] * cs.y; }
                u32x2 w; w.x = pk2(r1[0], r1[1]); w.y = pk2(r1[2], r1[3]); *(u32x2*)(d0 + row * pitch + 4 * n) = w;
                w.x = pk2(r2[0], r2[1]); w.y = pk2(r2[2], r2[3]); *(u32x2*)(d0 + row * pitch + 64 + 4 * n) = w;
                if (isq) { w.x = pk2(x1[0], x1[1]); w.y = pk2(x1[2], x1[3]); *(u32x2*)(dq + row * pitch + 4 * n) = w;
                           w.x = pk2(x2[0], x2[1]); w.y = pk2(x2[2], x2[3]); *(u32x2*)(dq + row * pitch + 64 + 4 * n) = w; } }
        EPI_ROWS_END
    }
};
struct EpiKV {
    static constexpr bool PERM = true; bf16_t *KCMP, *VCMP, *VSLC, *VWIN; const float* rss;
    __device__ __forceinline__ void operator()(const AccT& acc, const pg8::Unit& u, int wr, int wc, int fr, int fq) const {
        const int row0 = u.pm * 256 + wr * 64 + fr; bf16_t* d = (u.pn == 0 ? KCMP : u.pn == 1 ? VCMP : u.pn == 2 ? VSLC : VWIN) + wc * 32 + 8 * fq; const size_t hs = (u.pn <= 1 ? (size_t)KVROWS : (size_t)T_) * 128;
        EPI_ROWS_BEGIN EPI_RS
#pragma unroll
            for (int bj = 0; bj < 2; ++bj) *(u32x4*)(d + bj * hs + row * 128) = pack8(acc[ai][bj][m][0] * rs_, acc[ai][bj][m][1] * rs_);
        EPI_ROWS_END
    }
};
struct EpiGates {
    static constexpr bool PERM = true; bf16_t* GATES; float* CG; const float* rss;
    __device__ __forceinline__ void operator()(const AccT& acc, const pg8::Unit& u, int wr, int wc, int fr, int fq) const {
        const int row0 = u.pm * 256 + wr * 64 + fr;
        if (u.pn == 0) {
            if (wc == 0 && fq < 3) {
                EPI_ROWS_BEGIN EPI_RS
#pragma unroll
                    for (int e = 0; e < 8; ++e) { const int col = 8 * fq + e; if (col < 18) CG[row * 18 + col] = sigmoidf_(acc[ai][0][m][e >> 2][e & 3] * rs_); }
                EPI_ROWS_END
            }
            return;
        }
        const int gi = u.pn - 1; bf16_t* d = GATES + (size_t)(gi >> 3) * T_ * DM + (gi & 7) * 256 + wc * 32 + 8 * fq;
        EPI_ROWS_BEGIN EPI_RS
#pragma unroll
            for (int bj = 0; bj < 2; ++bj) { f32x4 o0, o1;
#pragma unroll
                for (int e = 0; e < 4; ++e) { o0[e] = sigmoidf_(acc[ai][bj][m][0][e] * rs_); o1[e] = sigmoidf_(acc[ai][bj][m][1][e] * rs_); }
                *(u32x4*)(d + row * DM + bj * 128) = pack8(o0, o1); }
        EPI_ROWS_END
    }
};

template <bool FIRST> struct EpiMerge {
    static constexpr bool PERM = true;
    bf16_t* Y; const bf16_t* G;
    __device__ __forceinline__ void operator()(const AccT& acc, const pg8::Unit& u, int wr, int wc, int fr, int fq) const {
        const int row0 = u.pm * 256 + wr * 64 + fr, c0 = u.pn * 256 + wc * 32 + 8 * fq;
#pragma unroll
        for (int ai = 0; ai < 2; ++ai)
#pragma unroll
            for (int m = 0; m < 4; ++m) { int rowi = row0 + ai * 128 + m * 16; asm volatile("" : "+v"(rowi)); const size_t row = rowi;
#pragma unroll
                for (int bj = 0; bj < 2; ++bj) { const size_t off = row * DM + c0 + bj * 128; const u32x4 g = *(const u32x4*)(G + off); u32x4 y = {0u, 0u, 0u, 0u}; if (!FIRST) y = *(const u32x4*)(Y + off);
                    f32x4 o0, o1; const f32x4 a0 = acc[ai][bj][m][0], a1 = acc[ai][bj][m][1];
                    o0[0] = bflo(y.x) + bflo(g.x) * a0[0]; o0[1] = bfhi(y.x) + bfhi(g.x) * a0[1]; o0[2] = bflo(y.y) + bflo(g.y) * a0[2]; o0[3] = bfhi(y.y) + bfhi(g.y) * a0[3];
                    o1[0] = bflo(y.z) + bflo(g.z) * a1[0]; o1[1] = bfhi(y.z) + bfhi(g.z) * a1[1]; o1[2] = bflo(y.w) + bflo(g.w) * a1[2]; o1[3] = bfhi(y.w) + bfhi(g.w) * a1[3];
                    *(u32x4*)(Y + off) = pack8(o0, o1); }
                asm volatile("" ::: "memory"); }
    }
};

struct EpiResid {
    static constexpr bool PERM = false;
    const float* xin; float* xout; bf16_t* xb; float* rss;
    __device__ __forceinline__ void operator()(const AccT& acc, const pg8::Unit& u, int wr, int wc, int fr, int fq) const {
        const int row0 = u.pm * 256 + wr * 64 + fr, c0 = u.pn * 256 + wc * 32 + 4 * fq, lane = fq * 16 + fr;
#pragma unroll
        for (int ai = 0; ai < 2; ++ai)
#pragma unroll
            for (int m = 0; m < 4; ++m) { int rowi = row0 + ai * 128 + m * 16; asm volatile("" : "+v"(rowi)); const size_t row = rowi; float ss = 0.f;
#pragma unroll
                for (int bj = 0; bj < 2; ++bj)
#pragma unroll
                    for (int n = 0; n < 2; ++n) { const size_t off = row * DM + c0 + bj * 128 + n * 16; const f32x4 xv = *(const f32x4*)(xin + off); const f32x4 r = xv + acc[ai][bj][m][n]; *(f32x4*)(xout + off) = r;
                        if (xb) { u32x2 w; w.x = pk2(r[0], r[1]); w.y = pk2(r[2], r[3]); *(u32x2*)(xb + off) = w; ss += (r[0] * r[0] + r[1] * r[1]) + (r[2] * r[2] + r[3] * r[3]); } }
                if (xb) { ss += shx(ss, 16, lane); ss += shx(ss, 32, lane); if (fq == 0) __hip_atomic_fetch_add(rss + row, ss, __ATOMIC_RELAXED, __HIP_MEMORY_SCOPE_AGENT); }
                asm volatile("" ::: "memory"); }
    }
};

struct EpiRelu2 {
    static constexpr bool PERM = true;
    bf16_t* Hd; const float* rss;
    __device__ __forceinline__ void operator()(const AccT& acc, const pg8::Unit& u, int wr, int wc, int fr, int fq) const {
        const int row0 = u.pm * 256 + wr * 64 + fr, c0 = u.pn * 256 + wc * 32 + 8 * fq;
#pragma unroll
        for (int ai = 0; ai < 2; ++ai)
#pragma unroll
            for (int m = 0; m < 4; ++m) { int rowi = row0 + ai * 128 + m * 16; asm volatile("" : "+v"(rowi)); const size_t row = rowi; const float rs_ = rsqrtf(rss[row] * (1.0f / DM) + NORM_EPS);
#pragma unroll
                for (int bj = 0; bj < 2; ++bj) { f32x4 o0 = acc[ai][bj][m][0] * rs_, o1 = acc[ai][bj][m][1] * rs_;
#pragma unroll
                    for (int e = 0; e < 4; ++e) { const float a = fmaxf(o0[e], 0.f), b = fmaxf(o1[e], 0.f); o0[e] = a * a; o1[e] = b * b; }
                    *(u32x4*)(Hd + row * DFF + c0 + bj * 128) = pack8(o0, o1); } }
    }
};

__device__ __forceinline__ float expm1_small(float y) {
    return y * (1.0f + y * (0.5f + y * (0.16666667f + y * (0.041666668f + y * (0.0083333338f + y * 0.0013888889f)))));
}
struct EpiGate {
    static constexpr bool PERM = true;
    const bf16_t* XC; float* Aout; float* Bout; const float *ba, *bx, *spc;
    __device__ __forceinline__ void operator()(const AccT& acc, const pg8::Unit& u, int wr, int wc, int fr, int fq) const {
        const int row0 = u.pm * 256 + wr * 64 + fr, ch0 = u.pn * 128 + wc * 32 + 8 * fq;
        EPI_ROWS_BEGIN
#pragma unroll
            for (int n = 0; n < 2; ++n) { const int ch = ch0 + 4 * n; f32x4 tq4;
                { const f32x4 sp = *(const f32x4*)(spc + ch), bav = *(const f32x4*)(ba + ch); f32x4 av;
#pragma unroll
                  for (int e = 0; e < 4; ++e) { const float la = sp[e] * sigmoidf_(acc[ai][0][m][n][e] + bav[e]); av[e] = 1.0f + expm1_small(la); tq4[e] = __builtin_amdgcn_sqrtf(fmaxf(-expm1_small(2.0f * la), 0.f)); }
                  *(f32x4*)(Aout + row * DRNN + ch) = av; }
                asm volatile("" ::: "memory");
                { const f32x4 bxv = *(const f32x4*)(bx + ch); const u32x2 xw = *(const u32x2*)(XC + row * DRNN + ch); f32x4 bv;
                  bv[0] = tq4[0] * (sigmoidf_(acc[ai][1][m][n][0] + bxv[0]) * bflo(xw.x)); bv[1] = tq4[1] * (sigmoidf_(acc[ai][1][m][n][1] + bxv[1]) * bfhi(xw.x));
                  bv[2] = tq4[2] * (sigmoidf_(acc[ai][1][m][n][2] + bxv[2]) * bflo(xw.y)); bv[3] = tq4[3] * (sigmoidf_(acc[ai][1][m][n][3] + bxv[3]) * bfhi(xw.y));
                  *(f32x4*)(Bout + row * DRNN + ch) = bv; }
                asm volatile("" ::: "memory"); }
        EPI_ROWS_END
    }
};

struct EpiCmp {
    static constexpr bool PERM = false;
    float* PART;
    __device__ __forceinline__ void operator()(const AccT& acc, const pg8::Unit& u, int wr, int wc, int fr, int fq) const {
        const int kvh = u.pn >> 3, split = u.pn & 7, row0 = u.pm * 256 + wr * 64 + fr, c0 = wc * 32 + 4 * fq;
        float* base = PART + (size_t)(split * 4 + kvh) * 1024 * 128;
#pragma unroll
        for (int ai = 0; ai < 2; ++ai)
#pragma unroll
            for (int m = 0; m < 4; ++m) { int rowi = row0 + ai * 128 + m * 16; asm volatile("" : "+v"(rowi)); const size_t row = rowi;
#pragma unroll
                for (int n = 0; n < 2; ++n) *(f32x4*)(base + row * 128 + c0 + n * 16) = acc[ai][0][m][n]; }
    }
};

struct GateSched {
    const char* XC; const char* WG; int G, c;
    __device__ bool next(int i, pg8::Unit& u) const { const int L = i * G + c; if (L >= 64 * 6) return false; u.pm = L / 6; u.pn = L % 6;
        u.a = XC + ((size_t)u.pm * 256 * DRNN + u.pn * 128) * 2; u.b = WG + (size_t)u.pn * 256 * 128 * 2; return true; }
};
struct CmpSched {
    const char* KCMP; const char* VCMP; const char* W1K; const char* W1V; int G, c;
    __device__ bool next(int i, pg8::Unit& u) const { const int L = i * G + c; if (L >= 128) return false; const int split = L & 7, pm = (L >> 3) & 3, kvh = L >> 5, kv = kvh >> 1, h = kvh & 1;
        u.pm = pm; u.pn = kvh * 8 + split;
        u.a = (kv ? VCMP : KCMP) + ((size_t)h * KVROWS * 128 + (size_t)pm * 256 * 2048 + split * 512) * 2; u.b = (kv ? W1V : W1K) + (size_t)split * 512 * 2; return true; }
};

#define XB_TMO      128
#define XB_XCNT(j)  (256  + 64 * (j))
#define XB_XSUB(j)  (1280 + 64 * (j))
#define XB_XGEN(j)  (2304 + 64 * (j))
#define XB_TOP      3328
#define XB_TOPGEN   3392
#define XCD_BAR_WORDS 3456
#define XB_SPIN_CAP (1u << 18)

__device__ __forceinline__ unsigned xb_ld(unsigned* p)              { return __hip_atomic_load(p, __ATOMIC_RELAXED, __HIP_MEMORY_SCOPE_AGENT); }
__device__ __forceinline__ unsigned xb_add(unsigned* p, unsigned v) { return __hip_atomic_fetch_add(p, v, __ATOMIC_RELAXED, __HIP_MEMORY_SCOPE_AGENT); }
__device__ __forceinline__ unsigned xb_xcc_id() { return (unsigned)__builtin_amdgcn_s_getreg((3 << 11) | 20) & 0xFu; }
#define XB_SPIN(cond, bar) do { unsigned _sp = 0; while (cond) { __builtin_amdgcn_s_sleep(1); \
    if ((++_sp & 255u) == 0u) { if (xb_ld(&(bar)[XB_TMO])) break; if (_sp > XB_SPIN_CAP) { atomicAdd(&(bar)[XB_TMO], 1u); break; } } } } while (0)

struct XcdBarrier {
    unsigned* bar; unsigned x;
    volatile LAS unsigned* st;
};

__device__ __forceinline__ XcdBarrier xcd_barrier_post(unsigned* bar, volatile LAS unsigned* st) {
    XcdBarrier b; b.bar = bar; b.x = xb_xcc_id(); b.st = st;
    if (threadIdx.x == 0) (void)xb_add(&bar[XB_XCNT(b.x)], 1u);
    return b;
}
__device__ __forceinline__ void xcd_barrier_complete(unsigned* bar, unsigned x, unsigned& nloc, unsigned& nx) {
    const unsigned G = gridDim.x * gridDim.y * gridDim.z;
    unsigned sum, cnt, mine, sp = 0u;
    for (;;) {
        sum = 0u; cnt = 0u; mine = 0u;
#pragma unroll
        for (unsigned j = 0; j < 16; ++j) { const unsigned c = xb_ld(&bar[XB_XCNT(j)]); sum += c; cnt += (c > 0u) ? 1u : 0u; mine = (j == x) ? c : mine; }
        if (sum == G) break;
        __builtin_amdgcn_s_sleep(1);
        if ((++sp & 255u) == 0u) { if (xb_ld(&bar[XB_TMO])) break; if (sp > XB_SPIN_CAP) { atomicAdd(&bar[XB_TMO], 1u); break; } }
    }
    nloc = mine > 0u ? mine : 1u; nx = cnt > 0u ? cnt : 1u;
}

__device__ __forceinline__ void xcd_barrier(const XcdBarrier& b) {
    asm volatile("s_waitcnt vmcnt(0)" ::: "memory");
    __syncthreads();
    if (threadIdx.x == 0) {
        unsigned* bar = b.bar;
        __builtin_amdgcn_s_waitcnt(0);
        unsigned nloc = b.st[0], nx = b.st[1];
        if (nloc == 0u) { xcd_barrier_complete(bar, b.x, nloc, nx); b.st[0] = nloc; b.st[1] = nx; }
        const unsigned old = xb_add(&bar[XB_XSUB(b.x)], 1u);
        const unsigned gen = old / nloc;
        if (old + 1u == (gen + 1u) * nloc) {
            __builtin_amdgcn_fence(__ATOMIC_RELEASE, "agent");
            asm volatile("s_waitcnt vmcnt(0)" ::: "memory");
            const unsigned og = xb_add(&bar[XB_TOP], 1u);
            const unsigned tg = og / nx;
            if (og + 1u == (tg + 1u) * nx) xb_add(&bar[XB_TOPGEN], 1u);
            else XB_SPIN(xb_ld(&bar[XB_TOPGEN]) == tg, bar);
            __builtin_amdgcn_fence(__ATOMIC_ACQUIRE, "agent");
            xb_add(&bar[XB_XGEN(b.x)], 1u);
            asm volatile("s_waitcnt vmcnt(0)" ::: "memory");
        } else {
            XB_SPIN(xb_ld(&bar[XB_XGEN(b.x)]) == gen, bar);
            __builtin_amdgcn_fence(__ATOMIC_ACQUIRE, "agent");
            asm volatile("s_waitcnt vmcnt(0)" ::: "memory");
        }
    }
    __syncthreads();
}


__device__ __forceinline__ void xcd_census(unsigned* bar_in, volatile LAS unsigned* st) {
    unsigned long long bl_ = (unsigned long long)bar_in; asm volatile("" : "+v"(bl_)); unsigned* bar = (unsigned*)bl_;
    if (threadIdx.x == 0) { const unsigned x = xb_xcc_id(); (void)xb_add(&bar[XB_XCNT(x)], 1u); unsigned nloc, nx; xcd_barrier_complete(bar, x, nloc, nx); st[0] = nloc; st[1] = nx; }
    __syncthreads();
}
__device__ __forceinline__ void xcd_barrier_light(unsigned* bar_in, volatile LAS unsigned* st) {
    unsigned long long bl_ = (unsigned long long)bar_in; asm volatile("" : "+v"(bl_)); unsigned* bar = (unsigned*)bl_;
    asm volatile("s_waitcnt vmcnt(0)" ::: "memory");
    __syncthreads();
    if (threadIdx.x == 0) {
        __builtin_amdgcn_s_waitcnt(0);
        const unsigned x = xb_xcc_id(); const unsigned nloc = st[0], nx = st[1];
        const unsigned old = xb_add(&bar[XB_XSUB(x)], 1u);
        const unsigned gen = old / nloc;
        if (old + 1u == (gen + 1u) * nloc) {
            __builtin_amdgcn_fence(__ATOMIC_RELEASE, "agent");
            asm volatile("s_waitcnt vmcnt(0)" ::: "memory");
            const unsigned og = xb_add(&bar[XB_TOP], 1u);
            const unsigned tg = og / nx;
            if (og + 1u == (tg + 1u) * nx) xb_add(&bar[XB_TOPGEN], 1u);
            else XB_SPIN(xb_ld(&bar[XB_TOPGEN]) == tg, bar);
            __builtin_amdgcn_fence(__ATOMIC_ACQUIRE, "agent");
            xb_add(&bar[XB_XGEN(x)], 1u);
            asm volatile("s_waitcnt vmcnt(0)" ::: "memory");
        } else {
            XB_SPIN(xb_ld(&bar[XB_XGEN(x)]) == gen, bar);
            __builtin_amdgcn_fence(__ATOMIC_ACQUIRE, "agent");
            asm volatile("s_waitcnt vmcnt(0)" ::: "memory");
        }
    }
    __syncthreads();
}

__device__ __forceinline__ int win_src_col(int dr) {
    const int pn = dr >> 8, j = dr & 255;
    if (pn < 4) return (j < 128) ? pn * 128 + j : 512 + pn * 128 + (j - 128);
    if (pn < 7) return 1024 + (pn - 4) * 256 + j;
    if (pn < 10) return 1792 + (pn - 7) * 256 + j;
    const int rh = (j & 127) >> 6, rd = (j >> 7) * 64 + (j & 63);
    if (pn < 13) return 2560 + (2 * (pn - 10) + rh) * 128 + rd;
    if (pn == 13) return 3840 + rh * 128 + rd;
    if (pn == 14) return 4352 + rh * 128 + rd;
    if (pn == 15) return 3328 + j;
    if (pn == 16) return 3584 + j;
    if (pn == 17) return 4096 + j;
    if (pn == 18) return 4608 + j;
    if (pn == 19) return j < 18 ? 4864 + j : -1;
    return 4882 + (pn - 20) * 256 + j;
}
typedef float f32x4_u __attribute__((ext_vector_type(4), aligned(4)));
template <int MODE> __device__ __forceinline__ void tr_load(f32x4 (&tv)[16], const float* W, int Nsrc, int n0, int k0, int lane, const float* kscale) {
    const int n4 = (lane & 15) * 4, kq = lane >> 4;
    const int dr = n0 + n4; const int sc = MODE ? win_src_col(dr) : (dr < Nsrc ? dr : -1);
    const bool irregular = MODE && (dr >> 8) == 19;
    if (irregular) {
#pragma unroll
        for (int i = 0; i < 16; ++i) { const float* wp = W + (size_t)(k0 + kq + 4 * i) * Nsrc;
#pragma unroll
            for (int e = 0; e < 4; ++e) { const int c = win_src_col(dr + e); tv[i][e] = c >= 0 ? wp[c] : 0.f; } }
    } else if (sc >= 0) {
#pragma unroll
        for (int i = 0; i < 16; ++i) tv[i] = *(const f32x4_u*)(W + (size_t)(k0 + kq + 4 * i) * Nsrc + sc);
    } else {
#pragma unroll
        for (int i = 0; i < 16; ++i) tv[i] = (f32x4){0.f, 0.f, 0.f, 0.f};
    }
    if (kscale) {
#pragma unroll
        for (int i = 0; i < 16; ++i) tv[i] *= kscale[k0 + kq + 4 * i]; }
}
__device__ __forceinline__ void tr_store(const f32x4 (&tv)[16], int K, bf16_t* WT, int n0, int k0, LAS float* scr, int lane) {
    const int n4 = (lane & 15) * 4, kq = lane >> 4;
#pragma unroll
    for (int i = 0; i < 16; ++i) { LAS float* d = scr + (kq + 4 * i) * 65 + n4; d[0] = tv[i][0]; d[1] = tv[i][1]; d[2] = tv[i][2]; d[3] = tv[i][3]; }
    LDS_WAIT(); asm volatile("" ::: "memory");
    const int c = lane & 7;
#pragma unroll
    for (int j = 0; j < 8; ++j) { const int n = (lane >> 3) + 8 * j; const LAS float* sp = scr + (8 * c) * 65 + n;
        u32x4 o; o.x = pk2(sp[0 * 65], sp[1 * 65]); o.y = pk2(sp[2 * 65], sp[3 * 65]); o.z = pk2(sp[4 * 65], sp[5 * 65]); o.w = pk2(sp[6 * 65], sp[7 * 65]);
        *(u32x4*)(WT + (size_t)(n0 + n) * K + k0 + 8 * c) = o; }
    LDS_WAIT(); asm volatile("" ::: "memory");
}
template <int MODE> __device__ __forceinline__ void convert_matrix(const float* W, int K, int Nsrc, int Ndst, bf16_t* WT, LAS float* scr, int lane, int gw, int NGW, const float* kscale = nullptr) {
    const int nblk = Ndst / 64, KB = K / 64, kgs = (KB + 7) / 8, tasks = nblk * kgs, wv = gw & 7, G = NGW >> 3;
    f32x4 cur[16], nxt[16];
    int tt = gw >> 3, nb = 0, kb = 0; bool ok = false;
    if (tt < tasks) { nb = tt % nblk; kb = (tt / nblk) * 8 + wv; ok = kb < KB; if (ok) tr_load<MODE>(cur, W, Nsrc, nb * 64, kb * 64, lane, kscale); }
    while (tt < tasks) {
        const int tn = tt + G; int nb2 = 0, kb2 = 0; bool ok2 = false;
        if (tn < tasks) { nb2 = tn % nblk; kb2 = (tn / nblk) * 8 + wv; ok2 = kb2 < KB; if (ok2) tr_load<MODE>(nxt, W, Nsrc, nb2 * 64, kb2 * 64, lane, kscale); }
        if (ok) tr_store(cur, K, WT, nb * 64, kb * 64, scr, lane);
#pragma unroll
        for (int i = 0; i < 16; ++i) cur[i] = nxt[i];
        tt = tn; nb = nb2; kb = kb2; ok = ok2;
    }
}

typedef __attribute__((address_space(4))) const unsigned char* kaptr_t;
__device__ __forceinline__ unsigned long long karg_u64(int byte_off) { kaptr_t ka = (kaptr_t)__builtin_amdgcn_kernarg_segment_ptr(); asm volatile("" : "+s"(ka)); return *(__attribute__((address_space(4))) const unsigned long long*)(ka + byte_off); }
#define GAS1 __attribute__((address_space(1)))
__device__ __forceinline__ unsigned char* ws_at(const Params& p, size_t off) { asm volatile("" : "+s"(off)); return (unsigned char*)((GAS1 unsigned char*)karg_u64((int)__builtin_offsetof(Params, ws)) + off); }
__device__ __forceinline__ const float* in_at(const Params& p, int i, size_t off) { asm volatile("" : "+s"(off)); return (const float*)((GAS1 const float*)karg_u64(i * 8) + off); }
__device__ __forceinline__ float* out_at(const Params& p) { return (float*)(GAS1 float*)karg_u64((int)__builtin_offsetof(Params, out)); }
__device__ __forceinline__ int fresh_s(int v) { asm volatile("" : "+s"(v)); return v; }
__device__ __forceinline__ int fresh_tid(int wid0) { int w = wid0; asm volatile("" : "+s"(w)); int ln; asm volatile("v_mbcnt_lo_u32_b32 %0, -1, 0\n\tv_mbcnt_hi_u32_b32 %0, -1, %0" : "=&v"(ln)); return w * 64 + ln; }
__global__ void __launch_bounds__(512, 2) fwd_kernel(Params p) {
    extern __shared__ __attribute__((aligned(16))) unsigned char lds_raw[];
    LAS unsigned char* lds = (LAS unsigned char*)lds_raw;
    cg::grid_group grid = cg::this_grid();
    const int wid0 = __builtin_amdgcn_readfirstlane((int)threadIdx.x >> 6);
    const int G0 = gridDim.x, bid0 = blockIdx.x;
#define WSP(T, off) ((T*)ws_at(p, (off)))
#define X (out_at(p))
#define P_ROPE WSP(f32x2, WS_ROPE)
#define P_WIN WSP(bf16_t, WS_WIN)
#define P_WCO WSP(bf16_t, WS_WCO)
#define P_WRO WSP(bf16_t, WS_WRO)
#define P_WAO WSP(bf16_t, WS_WAO)
#define P_WO WSP(bf16_t, WS_WO)
#define P_WUP WSP(bf16_t, WS_WUP)
#define P_WDN WSP(bf16_t, WS_WDN)
#define P_WG WSP(bf16_t, WS_WG)
#define P_W1K WSP(bf16_t, WS_W1K)
#define P_W1V WSP(bf16_t, WS_W1V)
#define P_ACT WSP(bf16_t, WS_ACT)
#define P_HB WSP(bf16_t, WS_H)
#define P_ABUF WSP(float, WS_H)
#define P_YB WSP(bf16_t, WS_H)
#define P_HID WSP(bf16_t, WS_H)
#define P_UB WSP(bf16_t, WS_U)
#define P_RX WSP(bf16_t, WS_R1 + 16 * MiB)
#define P_BBUF WSP(float, WS_R1)
#define P_TMPO WSP(float, WS_R1)
#define P_XC WSP(bf16_t, WS_XC)
#define P_OC WSP(bf16_t, WS_XC)
#define P_GG WSP(bf16_t, WS_GG)
#define P_QB WSP(bf16_t, WS_Q)
#define P_QR WSP(bf16_t, WS_QR)
#define P_KCMP WSP(bf16_t, WS_KCMP)
#define P_VCMP WSP(bf16_t, WS_VCMP)
#define P_KSLC WSP(bf16_t, WS_KSLC)
#define P_VSLC WSP(bf16_t, WS_VSLC)
#define P_KWIN WSP(bf16_t, WS_KWIN)
#define P_VWIN WSP(bf16_t, WS_VWIN)
#define P_CG WSP(float, WS_CG)
#define P_GATES WSP(bf16_t, WS_GATES)
#define P_PART WSP(float, WS_PART)
#define P_KC WSP(float, WS_KC)
#define P_VC WSP(float, WS_VC)
#define P_SEL WSP(unsigned, WS_SEL)
#define P_BPART WSP(float, WS_CTL + CTL_BPART)
#define P_SPC WSP(float, WS_CTL + CTL_SPC)
#define P_RSS WSP(float, WS_CTL + CTL_RSS)

#ifndef ENABLE_MASK
#define ENABLE_MASK 0xffffu
#endif
    {
        if (threadIdx.x < 2) ((LAS unsigned*)(lds + LDS_BYTES - 16))[threadIdx.x] = 0u;
        __syncthreads(); }
    xcd_census((unsigned*)ws_at(p, WS_CTL + CTL_BAR), (volatile LAS unsigned*)(lds + LDS_BYTES - 16));
    int phase = 0;
#define PH_BEGIN(k) if (((ENABLE_MASK >> (k)) & 1u) && phase >= p.ph_lo && phase < p.ph_hi) { \
        const int tid = fresh_tid(wid0); const int lane = tid & 63; const int wid = fresh_s(wid0), G = fresh_s(G0), bid = fresh_s(bid0); const int gw = bid * 8 + wid, NGW = G * 8; \
        (void)tid; (void)lane; (void)gw; (void)NGW;
#define PH_END   if (phase + 1 < p.ph_hi) { if (p.ph_hi < 0) grid.sync();   else xcd_barrier_light((unsigned*)ws_at(p, WS_CTL + CTL_BAR), (volatile LAS unsigned*)(lds + LDS_BYTES - 16)); } } ++phase;

    for (int l = 0; l < NLAYER; ++l) {
        const size_t lz = (size_t)l;
#define P_xin ((l == 0) ? in_at(p, 0, 0) : (const float*)X)
#define P_attn_norm_g in_at(p, 1, lz * DM)
#define P_w_in in_at(p, 2, lz * DM * NIN)
#define P_conv_dw_w in_at(p, 3, lz * 31 * DCONV)
#define P_conv_dw_b in_at(p, 4, lz * DCONV)
#define P_conv_ln_g in_at(p, 5, lz * DCONV)
#define P_conv_ln_b in_at(p, 6, lz * DCONV)
#define P_w_conv_out in_at(p, 7, lz * DCONV * DM)
#define P_rnn_conv_w in_at(p, 8, lz * 4 * DRNN)
#define P_rnn_conv_b in_at(p, 9, lz * DRNN)
#define P_rglru_wa in_at(p, 10, lz * 6 * 128 * 128)
#define P_rglru_ba in_at(p, 11, lz * DRNN)
#define P_rglru_wx in_at(p, 12, lz * 6 * 128 * 128)
#define P_rglru_bx in_at(p, 13, lz * DRNN)
#define P_rglru_lambda in_at(p, 14, lz * DRNN)
#define P_w_rnn_out in_at(p, 15, lz * DRNN * DM)
#define P_cmp_pe in_at(p, 16, lz * 32 * 128)
#define P_cmp_k_w1 in_at(p, 17, lz * 4096 * 128)
#define P_cmp_k_w2 in_at(p, 18, lz * 128 * 128)
#define P_cmp_v_w1 in_at(p, 19, lz * 4096 * 128)
#define P_cmp_v_w2 in_at(p, 20, lz * 128 * 128)
#define P_w_attn_out in_at(p, 21, lz * DATT * DM)
#define P_w_o in_at(p, 22, lz * DM * DM)
#define P_mlp_norm_g in_at(p, 23, lz * DM)
#define P_w_mlp_up in_at(p, 24, lz * DM * DFF)
#define P_w_mlp_down in_at(p, 25, lz * DFF * DM)

        PH_BEGIN(0)
        const auto ROPE = P_ROPE;
        const auto WIN = P_WIN;
        const auto WCO = P_WCO;
        const auto WRO = P_WRO;
        const auto WAO = P_WAO;
        const auto WO = P_WO;
        const auto WUP = P_WUP;
        const auto WDN = P_WDN;
        const auto WG = P_WG;
        const auto W1K = P_W1K;
        const auto W1V = P_W1V;
        const auto HB = P_HB;
        const auto xin = P_xin;
        const auto attn_norm_g = P_attn_norm_g;
        const auto w_in = P_w_in;
        const auto w_conv_out = P_w_conv_out;
        const auto rglru_wa = P_rglru_wa;
        const auto rglru_wx = P_rglru_wx;
        const auto w_rnn_out = P_w_rnn_out;
        const auto cmp_k_w1 = P_cmp_k_w1;
        const auto cmp_v_w1 = P_cmp_v_w1;
        const auto w_attn_out = P_w_attn_out;
        const auto w_o = P_w_o;
        const auto mlp_norm_g = P_mlp_norm_g;
        const auto w_mlp_up = P_w_mlp_up;
        const auto w_mlp_down = P_w_mlp_down;
        {
            LAS float* scr = (LAS float*)(lds + wid * 16640);
            convert_matrix<1>(w_in, DM, NIN, NINP, WIN, scr, lane, gw, NGW, attn_norm_g);
            convert_matrix<0>(w_mlp_up, DM, DFF, DFF, WUP, scr, lane, gw, NGW, mlp_norm_g);
            convert_matrix<0>(w_mlp_down, DFF, DM, DM, WDN, scr, lane, gw, NGW);
            convert_matrix<0>(w_o, DM, DM, DM, WO, scr, lane, gw, NGW);
            convert_matrix<0>(w_conv_out, DCONV, DM, DM, WCO, scr, lane, gw, NGW);
            convert_matrix<0>(w_rnn_out, DRNN, DM, DM, WRO, scr, lane, gw, NGW);
            convert_matrix<0>(w_attn_out, DATT, DM, DM, WAO, scr, lane, gw, NGW);
            convert_matrix<0>(cmp_k_w1, 4096, 128, 256, W1K, scr, lane, gw, NGW);
            convert_matrix<0>(cmp_v_w1, 4096, 128, 256, W1V, scr, lane, gw, NGW);
            for (int n = 0; n < 6; ++n) {
                convert_matrix<0>(rglru_wa + n * 16384, 128, 128, 128, WG + n * 256 * 128, scr, lane, gw, NGW);
                convert_matrix<0>(rglru_wx + n * 16384, 128, 128, 128, WG + n * 256 * 128 + 128 * 128, scr, lane, gw, NGW);
            }
            { const auto lam_ = P_rglru_lambda; const auto spc_ = P_SPC;
              for (int e = bid * 512 + tid; e < DRNN; e += G * 512) { const float ex = __expf(-lam_[e]);
                  spc_[e] = -8.0f * (ex * (1.0f + ex * (-0.5f + ex * (0.33333334f + ex * (-0.25f + ex * 0.2f))))); } }
            if (l == 0) {
                for (int e = bid * 512 + tid; e < SEQ * 64; e += G * 512) { const int pos = e >> 6, i = e & 63;
                    const float inv = __builtin_amdgcn_exp2f(-(float)i * 0.20762050593046014f);
                    const float rev = ((float)pos * inv) * 0.15915494309189535f; const float fr_ = rev - floorf(rev);
                    ROPE[e] = (f32x2){__builtin_amdgcn_cosf(fr_), __builtin_amdgcn_sinf(fr_)}; }
            }
            if (l == 0) for (int m = gw; m < T_; m += NGW) { const f32x4* xr = (const f32x4*)(xin + (size_t)m * DM) + lane; f32x4 v[8]; float s = 0.f;
#pragma unroll
                for (int j = 0; j < 8; ++j) { v[j] = xr[64 * j]; s += (v[j].x * v[j].x + v[j].y * v[j].y) + (v[j].z * v[j].z + v[j].w * v[j].w); }
                const float rstd = rsqrtf(wave_sum(s, lane) * (1.f / DM) + NORM_EPS);
                u32x2* o8 = (u32x2*)(HB + (size_t)m * DM) + lane;
#pragma unroll
                for (int j = 0; j < 8; ++j) { u32x2 w; w.x = pk2(v[j].x * rstd, v[j].y * rstd); w.y = pk2(v[j].z * rstd, v[j].w * rstd); o8[64 * j] = w; }
            }
            __syncthreads();
        }
        PH_END

        PH_BEGIN(1)
        const auto ROPE = P_ROPE;
        const auto WIN = P_WIN;
        const auto HB = P_HB;
        const auto UB = P_UB;
        const auto RX = P_RX;
        const auto GG = P_GG;
        const auto QB = P_QB;
        const auto QR = P_QR;
        const auto KCMP = P_KCMP;
        const auto VCMP = P_VCMP;
        const auto KSLC = P_KSLC;
        const auto VSLC = P_VSLC;
        const auto KWIN = P_KWIN;
        const auto VWIN = P_VWIN;
        const auto CG = P_CG;
        const auto GATES = P_GATES;
        {
            const bf16_t* Ain = (l == 0) ? (const bf16_t*)HB : (const bf16_t*)P_ACT; const float* rss = (l == 0) ? (const float*)nullptr : (const float*)(P_RSS + (size_t)(2 * (l - 1) + 1) * T_);
            { pg8::StdSched S; S.init(Ain, DM, WIN, DM, T_, 4 * 256, G, bid); EpiGLU E{UB, rss}; pg8::gemm_phase(lds, tid, DM, DM, DM, S, E); }
            { pg8::StdSched S; S.init(Ain, DM, WIN + (size_t)4 * 256 * DM, DM, T_, 6 * 256, G, bid); EpiRnnIn E{RX, GG, rss}; pg8::gemm_phase(lds, tid, DM, DM, DM, S, E); }
            { pg8::StdSched S; S.init(Ain, DM, WIN + (size_t)10 * 256 * DM, DM, T_, 5 * 256, G, (bid + 128) % G); EpiRope E{QB, QR, KSLC, KWIN, ROPE, rss}; pg8::gemm_phase(lds, tid, DM, DM, DM, S, E); }
            { pg8::StdSched S; S.init(Ain, DM, WIN + (size_t)15 * 256 * DM, DM, T_, 4 * 256, G, bid); EpiKV E{KCMP, VCMP, VSLC, VWIN, rss}; pg8::gemm_phase(lds, tid, DM, DM, DM, S, E); }
            { pg8::StdSched S; S.init(Ain, DM, WIN + (size_t)19 * 256 * DM, DM, T_, 25 * 256, G, (bid + 64) % G); EpiGates E{GATES, CG, rss}; pg8::gemm_phase(lds, tid, DM, DM, DM, S, E); }
        }
        PH_END

        PH_BEGIN(2)
        const auto W1K = P_W1K;
        const auto W1V = P_W1V;
        const auto RX = P_RX;
        const auto XC = P_XC;
        const auto KCMP = P_KCMP;
        const auto VCMP = P_VCMP;
        const auto PART = P_PART;
        const auto BPART = P_BPART;
        const auto rnn_conv_w = P_rnn_conv_w;
        const auto rnn_conv_b = P_rnn_conv_b;
        const auto cmp_pe = P_cmp_pe;
        const auto cmp_k_w1 = P_cmp_k_w1;
        const auto cmp_v_w1 = P_cmp_v_w1;
        {
            { CmpSched S{(const char*)KCMP, (const char*)VCMP, (const char*)W1K, (const char*)W1V, G, bid}; EpiCmp E{PART}; pg8::gemm_phase(lds, tid, 512, 2048, 4096, S, E); }
            __syncthreads();
            for (size_t e = (size_t)bid * 512 + tid; e < (size_t)T_ * DRNN / 8; e += (size_t)G * 512) {
                const int row = (int)(e / (DRNN / 8)), c0 = (int)(e % (DRNN / 8)) * 8, pos = row & (SEQ - 1);
                float o[8];
#pragma unroll
                for (int i = 0; i < 8; ++i) o[i] = rnn_conv_b[c0 + i];
#pragma unroll
                for (int j = 0; j < 4; ++j) { if (pos - 3 + j >= 0) { const u32x4 xw = *(const u32x4*)(RX + (size_t)(row - 3 + j) * DRNN + c0); const float* wj = rnn_conv_w + j * DRNN + c0;
                        o[0] += wj[0] * bflo(xw.x); o[1] += wj[1] * bfhi(xw.x); o[2] += wj[2] * bflo(xw.y); o[3] += wj[3] * bfhi(xw.y);
                        o[4] += wj[4] * bflo(xw.z); o[5] += wj[5] * bfhi(xw.z); o[6] += wj[6] * bflo(xw.w); o[7] += wj[7] * bfhi(xw.w); } }
                u32x4 w; w.x = pk2(o[0], o[1]); w.y = pk2(o[2], o[3]); w.z = pk2(o[4], o[5]); w.w = pk2(o[6], o[7]);
                *(u32x4*)(XC + (size_t)row * DRNN + c0) = w;
            }
            {
                LAS float* red = (LAS float*)lds;
                for (int item = bid - 128; item >= 0 && item < 32; item += G) { const int kv = item >> 4, kc = item & 15, kg = tid >> 7, j = tid & 127; const float* w1 = kv ? cmp_v_w1 : cmp_k_w1;
                    float s = 0.f;
#pragma unroll 16
                    for (int i = 0; i < 64; ++i) { const int k = kc * 256 + kg * 64 + i; s += cmp_pe[k] * w1[(size_t)k * 128 + j]; }
                    red[kg * 128 + j] = s; __syncthreads();
                    if (tid < 128) BPART[(kc * 2 + kv) * 128 + tid] = (red[tid] + red[128 + tid]) + (red[256 + tid] + red[384 + tid]);
                    __syncthreads(); }
            }
        }
        PH_END

        PH_BEGIN(3)
        const auto WG = P_WG;
        const auto ABUF = P_ABUF;
        const auto BBUF = P_BBUF;
        const auto XC = P_XC;
        const auto PART = P_PART;
        const auto KC = P_KC;
        const auto VC = P_VC;
        const auto BPART = P_BPART;
        const auto rglru_ba = P_rglru_ba;
        const auto rglru_bx = P_rglru_bx;
        const auto cmp_k_w2 = P_cmp_k_w2;
        const auto cmp_v_w2 = P_cmp_v_w2;
        {
            { const auto SPC = P_SPC; GateSched S{(const char*)XC, (const char*)WG, G, bid}; EpiGate E{XC, ABUF, BBUF, rglru_ba, rglru_bx, SPC}; pg8::gemm_phase(lds, tid, 128, DRNN, 128, S, E); }
            __syncthreads();
            {
                                                                LAS float* hv = (LAS float*)lds;
                const int tid = fresh_tid(wid0); const int rr = tid >> 7, j = tid & 127;
                for (int it = bid; it < 1024; it += G) { const int r4 = it * 4 + rr, n = r4 & 127, h = (r4 >> 7) & 1, b = (r4 >> 8) & 7, kv = r4 >> 11;
                    float s = 0.f;
#pragma unroll
                    for (int sp = 0; sp < 8; ++sp) s += PART[((size_t)(sp * 4 + kv * 2 + h) * 1024 + b * 128 + n) * 128 + j];
#pragma unroll
                    for (int kc = 0; kc < 16; ++kc) s += BPART[(kc * 2 + kv) * 128 + j];
                    hv[rr * 128 + j] = gelu_tanh(s); __syncthreads();
                    const float* w2 = kv ? cmp_v_w2 : cmp_k_w2; float o = 0.f;
#pragma unroll 8
                    for (int k = 0; k < 128; ++k) o += hv[rr * 128 + k] * w2[k * 128 + j];
                    (kv ? VC : KC)[((size_t)(b * 2 + h) * 128 + n) * 128 + j] = (n < 127) ? o : 0.f;
                    __syncthreads(); }
            }
        }
        PH_END

        PH_BEGIN(5)
        const auto ACT = P_ACT;
        const auto OC = P_OC;
        const auto QB = P_QB;
        const auto QR = P_QR;
        const auto KSLC = P_KSLC;
        const auto VSLC = P_VSLC;
        const auto KWIN = P_KWIN;
        const auto VWIN = P_VWIN;
        const auto CG = P_CG;
        const auto KC = P_KC;
        const auto VC = P_VC;
        const auto SEL = P_SEL;
        {
            constexpr int KS_PITCH = 272, KS_BYTES = 64 * KS_PITCH, VT_PITCH = 288, VT_BYTES = 64 * VT_PITCH, QW_BYTES = 48 * KS_PITCH;
            LAS unsigned char* ks = lds; LAS unsigned char* vt = lds + KS_BYTES; LAS unsigned char* qw = lds + KS_BYTES + VT_BYTES + wid * QW_BYTES;
            for (int unit = bid; unit < NBATCH * 2 * 16; unit += G) {
                const int cb = 15 - (unit & 15), hkv = (unit >> 4) & 1, b = unit >> 5;
                {
                constexpr int CP = 272;
                LAS unsigned char* ks2 = lds; LAS unsigned char* vt2 = lds + 128 * CP;
                    int tc_ = fresh_tid(wid0); int ln_ = tc_ & 63; const int fr = ln_ & 15, fq = ln_ >> 4;
                    const float* kcg = KC + (size_t)(b * 2 + hkv) * 128 * 128; const float* vcg = VC + (size_t)(b * 2 + hkv) * 128 * 128;
                    __syncthreads();
#pragma unroll
                    for (int i = 0; i < 8; ++i) { const int idx = tc_ + 512 * i; { const int r = idx >> 5, c4 = (idx & 31) * 4; const f32x4 kv4 = *(const f32x4*)(kcg + r * 128 + c4); u32x2 w; w.x = pk2(kv4.x, kv4.y); w.y = pk2(kv4.z, kv4.w); *(LAS u32x2*)(ks2 + r * CP + c4 * 2) = w; }
                        { const int r = idx >> 5, c4 = (idx & 31) * 4; const f32x4 vv = *(const f32x4*)(vcg + r * 128 + c4); u32x2 w; w.x = pk2(vv.x, vv.y); w.y = pk2(vv.z, vv.w); *(LAS u32x2*)(vt2 + r * 288 + c4 * 2) = w; } }
                    __syncthreads();
                    const int tq = cb * 128 + wid * 16 + fr; const size_t trow = (size_t)b * SEQ + tq;
                    int nvis = (tq >= 31) ? ((tq - 31) >> 4) + 1 : 0; if (nvis > 127) nvis = 127;
                    unsigned vm = 0u;
#pragma unroll
                    for (int i = 0; i < 8; ++i)
#pragma unroll
                        for (int jj = 0; jj < 4; ++jj) vm |= ((16 * i + 4 * fq + jj < nvis) ? 1u : 0u) << (i * 4 + jj);
                    f32x4 pall[8];
#pragma unroll
                    for (int i = 0; i < 8; ++i) pall[i] = (f32x4){0.f, 0.f, 0.f, 0.f};
#pragma unroll
                    for (int g = 0; g < 3; ++g) {
                        bf16x8 qf[4];
#pragma unroll
                        for (int ds = 0; ds < 4; ++ds) qf[ds] = *(const bf16x8*)(QB + trow * DATT + (3 * hkv + g) * 128 + ds * 32 + fq * 8);
                        f32x4 S[8];
#pragma unroll
                        for (int i = 0; i < 8; ++i) { bf16x8 kf[4];
#pragma unroll
                            for (int ds = 0; ds < 4; ++ds) kf[ds] = *(const LAS bf16x8*)(ks2 + (i * 16 + fr) * CP + (ds * 32 + fq * 8) * 2);
                            f32x4 a = (f32x4){0.f, 0.f, 0.f, 0.f};
#pragma unroll
                            for (int ds = 0; ds < 4; ++ds) a = __builtin_amdgcn_mfma_f32_16x16x32_bf16(kf[ds], qf[ds], a, 0, 0, 0);
                            S[i] = a; }
                        float mx = -1e30f;
#pragma unroll
                        for (int i = 0; i < 8; ++i)
#pragma unroll
                            for (int jj = 0; jj < 4; ++jj) { const float sv = ((vm >> (i * 4 + jj)) & 1u) ? S[i][jj] : -1e30f; S[i][jj] = sv; mx = fmaxf(mx, sv); }
                        mx = fmaxf(mx, shx(mx, 16, ln_)); mx = fmaxf(mx, shx(mx, 32, ln_));
                        float psum = 0.f;
#pragma unroll
                        for (int i = 0; i < 8; ++i)
#pragma unroll
                            for (int jj = 0; jj < 4; ++jj) { const float pv = ((vm >> (i * 4 + jj)) & 1u) ? __builtin_amdgcn_exp2f(S[i][jj] - mx) : 0.f; S[i][jj] = pv; psum += pv; }
                        psum += shx(psum, 16, ln_); psum += shx(psum, 32, ln_);
                        const float inv = psum > 0.f ? 1.0f / psum : 0.f;
#pragma unroll
                        for (int i = 0; i < 8; ++i) { S[i] *= inv; pall[i] += S[i]; }
                        bf16x8 pb[4];
#pragma unroll
                        for (int pp = 0; pp < 4; ++pp) { u32x4 w; w.x = pk2(S[2 * pp][0], S[2 * pp][1]); w.y = pk2(S[2 * pp][2], S[2 * pp][3]); w.z = pk2(S[2 * pp + 1][0], S[2 * pp + 1][1]); w.w = pk2(S[2 * pp + 1][2], S[2 * pp + 1][3]);
                            pb[pp] = __builtin_bit_cast(bf16x8, w); }
                        const float gate = CG[trow * 18 + (3 * hkv + g) * 3 + 0];
#pragma unroll
                        for (int dt = 0; dt < 8; ++dt) { f32x4 o = (f32x4){0.f, 0.f, 0.f, 0.f};
#pragma unroll
                            for (int pp = 0; pp < 4; ++pp) { const LAS unsigned char* vp = vt2 + (32 * pp + 4 * fq + (fr >> 2)) * 288 + (dt * 16 + 4 * (fr & 3)) * 2;
                                const tr4_t lo = __builtin_amdgcn_ds_read_tr16_b64_v4i16((LAS tr4_t*)vp), hi = __builtin_amdgcn_ds_read_tr16_b64_v4i16((LAS tr4_t*)(vp + 16 * 288));
                                o = __builtin_amdgcn_mfma_f32_16x16x32_bf16((bf16x8){lo[0], lo[1], lo[2], lo[3], hi[0], hi[1], hi[2], hi[3]}, pb[pp], o, 0, 0, 0); }
                            o *= gate; u32x2 w; w.x = pk2(o[0], o[1]); w.y = pk2(o[2], o[3]);
                            *(u32x2*)(OC + trow * DATT + (3 * hkv + g) * 128 + dt * 16 + 4 * fq) = w; }
                        asm volatile("" ::: "memory");
                    }
                    float imp[8];
#pragma unroll
                    for (int i = 0; i < 8; ++i) { const float own = (pall[i][0] + pall[i][1]) + (pall[i][2] + pall[i][3]); const float v3 = pall[i][3]; const float prev3 = (i > 0) ? pall[i > 0 ? i - 1 : 0][3] : 0.f;
                        const float a = shidx(v3, (ln_ + 48) & 63), c = shidx(prev3, (ln_ + 48) & 63); imp[i] = own + (fq > 0 ? a : c); }
                    const int cur = (cb * 128 + wid * 16) >> 6; unsigned mask;
                    if (cur < 16) mask = (2u << cur) - 1u;
                    else { int rank[8] = {0, 0, 0, 0, 0, 0, 0, 0};
#pragma unroll
                        for (int i2 = 0; i2 < 8; ++i2)
#pragma unroll
                            for (int f2 = 0; f2 < 4; ++f2) { const float o = shidx(imp[i2], fr + 16 * f2); const int m2 = 4 * i2 + f2;
                                if (m2 >= 1 && m2 <= cur - 2) {
#pragma unroll
                                    for (int i = 0; i < 8; ++i) { const int m = 4 * i + fq; rank[i] += (o > imp[i] || (o == imp[i] && m2 < m)) ? 1 : 0; } } }
                        unsigned bits = 0u;
#pragma unroll
                        for (int i = 0; i < 8; ++i) { const int m = 4 * i + fq; if (m >= 1 && m <= cur - 2 && rank[i] < 13) bits |= 1u << m; }
                        bits |= shx(bits, 16, ln_); bits |= shx(bits, 32, ln_);
                        mask = bits | 1u | (1u << cur) | (1u << (cur - 1)); }
                    if (fq == 0) SEL[(size_t)(b * 2 + hkv) * SEQ + tq] = mask;
                }
                __syncthreads();
                int ln_ = fresh_tid(wid0) & 63; const int fr = ln_ & 15, fq = ln_ >> 4;
                const int tq = cb * 128 + wid * 16 + fr, tq_lo = cb * 128 + wid * 16, tq_hi = tq_lo + 15;
                const size_t trow_u = (size_t)b * SEQ + tq_lo;
                { const bf16_t* qu = QR + trow_u * DATT + (3 * hkv) * 128; const unsigned qo = (unsigned)fr * DATT + fq * 8;
#pragma unroll
                for (int g = 0; g < 3; ++g)
#pragma unroll
                    for (int ds = 0; ds < 4; ++ds) { const u32x4 v = *(const u32x4*)(qu + qo + g * 128 + ds * 32); *(LAS u32x4*)(qw + (g * 16 + fr) * KS_PITCH + (ds * 32 + fq * 8) * 2) = v; } }
                const unsigned selm = (SEL + (size_t)(b * 2 + hkv) * SEQ + tq_lo)[fr];
                for (int br = 0; br < 2; ++br) {
                    const bf16_t* Kb = (br == 0 ? KSLC : KWIN) + ((size_t)hkv * T_ + (size_t)b * SEQ) * 128;
                    const bf16_t* Vb = (br == 0 ? VSLC : VWIN) + ((size_t)hkv * T_ + (size_t)b * SEQ) * 128;
                    const int j1 = 2 * cb + 1, j0 = (br == 0) ? 0 : (2 * cb - 8 > 0 ? 2 * cb - 8 : 0);
                    f32x4 O[3][8];
#pragma unroll
                    for (int g = 0; g < 3; ++g)
#pragma unroll
                        for (int dt = 0; dt < 8; ++dt) O[g][dt] = (f32x4){0.f, 0.f, 0.f, 0.f};
                    float mrun[3] = {-1e30f, -1e30f, -1e30f}, lrun[3] = {0.f, 0.f, 0.f};
                    u32x4 kreg[2], vreg[2];
#define ATT_LOAD(j) do { const bf16_t* kt_ = Kb + (size_t)(j) * 64 * 128; const bf16_t* vtl_ = Vb + (size_t)(j) * 64 * 128; \
                        _Pragma("unroll") for (int i_ = 0; i_ < 2; ++i_) { kreg[i_] = *(const u32x4*)(kt_ + ((unsigned)tid * 8u + 4096u * i_)); \
                        vreg[i_] = *(const u32x4*)(vtl_ + ((unsigned)tid * 8u + 4096u * i_)); } } while (0)
#define ATT_STORE() do { _Pragma("unroll") for (int i_ = 0; i_ < 2; ++i_) { const int c_ = tid + 512 * i_; *(LAS u32x4*)(ks + (c_ >> 4) * KS_PITCH + (c_ & 15) * 16) = kreg[i_]; \
                            *(LAS u32x4*)(vt + (c_ >> 4) * VT_PITCH + (c_ & 15) * 16) = vreg[i_]; } } while (0)
                    ATT_LOAD(j0);
                    for (int j = j0; j <= j1; ++j) {
                        __syncthreads();
                        ATT_STORE();
                        __syncthreads();
                        if (j < j1) ATT_LOAD(j + 1);
                        bool active = (j * 64 <= tq_hi);
                        if (br == 1) active = active && (j * 64 + 63 > tq_lo - 512);
                        if (br == 0) active = active && (__ballot((selm >> j) & 1u) != 0ull);
                        if (active) {
                            unsigned vm = 0u;
#pragma unroll
                            for (int kq = 0; kq < 4; ++kq)
#pragma unroll
                                for (int jj = 0; jj < 4; ++jj) { const int kk = j * 64 + kq * 16 + 4 * fq + jj; bool ok = kk <= tq; if (br == 1) ok = ok && (kk > tq - 512); else ok = ok && ((selm >> j) & 1u); vm |= (ok ? 1u : 0u) << (kq * 4 + jj); }
                            bf16x8 pb[3][2];
#pragma unroll
                            for (int g = 0; g < 3; ++g) {
                                bf16x8 qf[4];
#pragma unroll
                                for (int ds = 0; ds < 4; ++ds) qf[ds] = *(const LAS bf16x8*)(qw + (g * 16 + fr) * KS_PITCH + (ds * 32 + fq * 8) * 2);
                                f32x4 S[4];
#pragma unroll
                                for (int kq = 0; kq < 4; ++kq) { bf16x8 kf[4];
#pragma unroll
                                    for (int ds = 0; ds < 4; ++ds) kf[ds] = *(const LAS bf16x8*)(ks + (kq * 16 + fr) * KS_PITCH + (ds * 32 + fq * 8) * 2);
                                    f32x4 a = (f32x4){0.f, 0.f, 0.f, 0.f};
#pragma unroll
                                    for (int ds = 0; ds < 4; ++ds) a = __builtin_amdgcn_mfma_f32_16x16x32_bf16(kf[ds], qf[ds], a, 0, 0, 0);
                                    S[kq] = a; }
                                float mx = -1e30f;
#pragma unroll
                                for (int kq = 0; kq < 4; ++kq)
#pragma unroll
                                    for (int jj = 0; jj < 4; ++jj) { const float sv = ((vm >> (kq * 4 + jj)) & 1u) ? S[kq][jj] : -1e30f; S[kq][jj] = sv; mx = fmaxf(mx, sv); }
                                mx = fmaxf(mx, shx(mx, 16, ln_)); mx = fmaxf(mx, shx(mx, 32, ln_));
                                if (__builtin_amdgcn_ballot_w64(mx > mrun[g] + 8.0f) != 0ull) {
                                    const float mnew_ = fmaxf(mrun[g], mx), alpha = __builtin_amdgcn_exp2f(mrun[g] - mnew_); mrun[g] = mnew_; lrun[g] *= alpha;
#pragma unroll
                                    for (int dt = 0; dt < 8; ++dt) O[g][dt] *= alpha; }
                                const float mnew = mrun[g];
                                float psum = 0.f;
#pragma unroll
                                for (int kq = 0; kq < 4; ++kq)
#pragma unroll
                                    for (int jj = 0; jj < 4; ++jj) { const float pv = ((vm >> (kq * 4 + jj)) & 1u) ? __builtin_amdgcn_exp2f(S[kq][jj] - mnew) : 0.f; S[kq][jj] = pv; psum += pv; }
                                lrun[g] += psum;
#pragma unroll
                                for (int pp = 0; pp < 2; ++pp) { u32x4 w; w.x = pk2(S[2 * pp][0], S[2 * pp][1]); w.y = pk2(S[2 * pp][2], S[2 * pp][3]); w.z = pk2(S[2 * pp + 1][0], S[2 * pp + 1][1]); w.w = pk2(S[2 * pp + 1][2], S[2 * pp + 1][3]);
                                    pb[g][pp] = __builtin_bit_cast(bf16x8, w); }
                                asm volatile("" ::: "memory");
                            }
                            __builtin_amdgcn_s_setprio(1);
#pragma unroll
                            for (int pp = 0; pp < 2; ++pp)
#pragma unroll
                                for (int dt = 0; dt < 8; ++dt) { const LAS unsigned char* vp = vt + (32 * pp + 4 * fq + (fr >> 2)) * VT_PITCH + (dt * 16 + 4 * (fr & 3)) * 2;
                                    const tr4_t lo = __builtin_amdgcn_ds_read_tr16_b64_v4i16((LAS tr4_t*)vp), hi = __builtin_amdgcn_ds_read_tr16_b64_v4i16((LAS tr4_t*)(vp + 16 * VT_PITCH));
                                    const bf16x8 vf = (bf16x8){lo[0], lo[1], lo[2], lo[3], hi[0], hi[1], hi[2], hi[3]};
#pragma unroll
                                    for (int g = 0; g < 3; ++g) O[g][dt] = __builtin_amdgcn_mfma_f32_16x16x32_bf16(vf, pb[g][pp], O[g][dt], 0, 0, 0);
                                    if ((dt & 3) == 3) asm volatile("" ::: "memory"); }
                            __builtin_amdgcn_s_setprio(0);
                        }
                    }
#undef ATT_LOAD
#undef ATT_STORE
                    { const float* cgu = CG + trow_u * 18 + (3 * hkv) * 3 + 1 + br; const unsigned lo768 = (unsigned)fr * DATT + 4 * fq, lo2048 = (unsigned)fr * DM + 4 * fq;
                      const bf16_t* ocu = OC + trow_u * DATT + (3 * hkv) * 128; bf16_t* acu = ACT + trow_u * DM + DCONV + DRNN + (3 * hkv) * 128;
#pragma unroll
                    for (int g = 0; g < 3; ++g) { float lt = lrun[g]; lt += shx(lt, 16, ln_); lt += shx(lt, 32, ln_);
                        const float gate = cgu[(unsigned)fr * 18 + g * 3]; const float sc = gate / lt;
#pragma unroll
                        for (int dt = 0; dt < 8; ++dt) { f32x4 r = O[g][dt] * sc;
                            if (br == 0) { const u32x2 pw = *(const u32x2*)(ocu + lo768 + g * 128 + dt * 16); r[0] += bflo(pw.x); r[1] += bfhi(pw.x); r[2] += bflo(pw.y); r[3] += bfhi(pw.y); }
                            else { const u32x2 pw = *(const u32x2*)(acu + lo2048 + g * 128 + dt * 16); r[0] += bflo(pw.x); r[1] += bfhi(pw.x); r[2] += bflo(pw.y); r[3] += bfhi(pw.y); }
                            u32x2 w; w.x = pk2(r[0], r[1]); w.y = pk2(r[2], r[3]); *(u32x2*)(acu + lo2048 + g * 128 + dt * 16) = w;
                            asm volatile("" ::: "memory"); } } }
                }
                __syncthreads();
            }
            {
                int tidf = tid; asm volatile("" : "+v"(tidf)); const int lanef = tidf & 63;
                const auto ABUF_f = P_ABUF;
                const auto BBUF_f = P_BBUF;
                const auto ACT_f = P_ACT;
                const auto GG_f = P_GG;
                const auto UB_f = P_UB;
                const auto conv_dw_w_f = P_conv_dw_w;
                const auto conv_dw_b_f = P_conv_dw_b;
                const auto conv_ln_g_f = P_conv_ln_g;
                const auto conv_ln_b_f = P_conv_ln_b;
                unsigned* qctr = (unsigned*)ws_at(p, WS_CTL + CTL_BAR + 14336) + l;
                LAS int* wslot = (LAS int*)(lds + LDS_BYTES - 32);
                for (;;) {
                    __syncthreads();
                    if (tidf == 0) *wslot = (int)__hip_atomic_fetch_add(qctr, 1u, __ATOMIC_RELAXED, __HIP_MEMORY_SCOPE_AGENT);
                    __syncthreads();
                    const int wk = __builtin_amdgcn_readfirstlane(*wslot);
                    if (wk >= 384 + 512) break;
                    int tw_ = tidf; asm volatile("" : "+v"(tw_)); const int ck = tw_ >> 4, j = tw_ & 15, lanew = tw_ & 63;
                    if (wk < 384) {
                        LAS float* Ps = (LAS float*)lds; LAS float* Hs = Ps + 512;
                        const int unit = wk; const int b = unit / (DRNN / 16), ch = (unit % (DRNN / 16)) * 16 + j;
                        const float* ab_u = ABUF_f + (size_t)b * SEQ * DRNN; const float* bb_u = BBUF_f + (size_t)b * SEQ * DRNN;
                        const unsigned voff = (unsigned)(ck * 64) * DRNN + ch;
                        float av[64], bv[64];
#pragma unroll
                        for (int s2 = 0; s2 < 64; ++s2) { av[s2] = (ab_u + (size_t)s2 * DRNN)[voff]; bv[s2] = (bb_u + (size_t)s2 * DRNN)[voff]; }
                        float P = 1.f, H = 0.f;
#pragma unroll
                        for (int s2 = 0; s2 < 64; ++s2) { P *= av[s2]; H = av[s2] * H + bv[s2]; }
                        Ps[tw_] = P; Hs[tw_] = H; __syncthreads();
                        float h = 0.f; for (int c2 = 0; c2 < ck; ++c2) h = Ps[c2 * 16 + j] * h + Hs[c2 * 16 + j];
                        const bf16_t* gg_u = GG_f + (size_t)b * SEQ * DRNN; bf16_t* act_u = ACT_f + (size_t)b * SEQ * DM + DCONV; const unsigned aoff = (unsigned)(ck * 64) * DM + ch;
#pragma unroll
                        for (int s2 = 0; s2 < 64; ++s2) { h = av[s2] * h + bv[s2];
                            (act_u + (size_t)s2 * DM)[aoff] = (bf16_t)f2bf(h * bf2f((gg_u + (size_t)s2 * DRNN)[voff])); }
                    } else {
                        LAS float* ct = (LAS float*)lds;
                        const int c = tw_, unit = wk - 384;
                        const int t0 = unit * 32, pos0 = t0 & (SEQ - 1);
                        float w[31];
#pragma unroll
                        for (int jj = 0; jj < 31; ++jj) w[jj] = (conv_dw_w_f + jj * DCONV)[(unsigned)c];
                        const float bias = conv_dw_b_f[c];
                        float acc[32];
#pragma unroll
                        for (int tt = 0; tt < 32; ++tt) acc[tt] = bias;
                        unsigned ccv = (unsigned)c;
#pragma unroll
                        for (int s2 = 0; s2 < 62; ++s2) {
                            const int pr = pos0 - 30 + s2;
                            if ((s2 & 7) == 0) asm volatile("" : "+v"(ccv)); float v = 0.f; if (pr >= 0) v = bf2f((UB_f + (size_t)(t0 - 30 + s2) * DCONV)[ccv]);
#pragma unroll
                            for (int tt = 0; tt < 32; ++tt) { const int jj = s2 - tt; if (jj >= 0 && jj <= 30) acc[tt] += w[jj] * v; }
                            if ((s2 & 7) == 7) asm volatile("" ::: "memory");
                        }
#pragma unroll
                        for (int tt = 0; tt < 32; ++tt) ct[tt * 512 + c] = acc[tt];
                        __syncthreads();
#pragma unroll
                        for (int q = 0; q < 4; ++q) { const int tt = wid * 4 + q; float v[8]; float sm = 0.f;
#pragma unroll
                            for (int i = 0; i < 8; ++i) { v[i] = ct[tt * 512 + lanew + 64 * i]; sm += v[i]; }
                            const float mu = wave_sum(sm, lanew) * (1.f / 512.f); float s2 = 0.f;
#pragma unroll
                            for (int i = 0; i < 8; ++i) { v[i] -= mu; s2 += v[i] * v[i]; }
                            const float rstd = rsqrtf(wave_sum(s2, lanew) * (1.f / 512.f) + NORM_EPS);
#pragma unroll
                            for (int i = 0; i < 8; ++i) { const int ch = lanew + 64 * i; const float y = v[i] * rstd * conv_ln_g_f[ch] + conv_ln_b_f[ch]; (ACT_f + (size_t)(t0 + tt) * DM)[(unsigned)ch] = (bf16_t)f2bf(y * sigmoidf_(y)); }
                        }
                    }
                }
            }
        }
        PH_END

        PH_BEGIN(6)
        const auto WCO = P_WCO;
        const auto WRO = P_WRO;
        const auto WAO = P_WAO;
        const auto ACT = P_ACT;
        const auto YB = P_YB;
        const auto GATES = P_GATES;
        {
            { pg8::StdSched S; S.init(ACT, DM, WCO, DCONV, T_, DM, G, bid); EpiMerge<true> E{YB, GATES}; pg8::gemm_phase(lds, tid, DCONV, DM, DCONV, S, E); }
            { pg8::StdSched S; S.init(ACT + DCONV, DM, WRO, DRNN, T_, DM, G, bid); EpiMerge<false> E{YB, GATES + (size_t)T_ * DM}; pg8::gemm_phase(lds, tid, DRNN, DM, DRNN, S, E); }
            { pg8::StdSched S; S.init(ACT + DCONV + DRNN, DM, WAO, DATT, T_, DM, G, bid); EpiMerge<false> E{YB, GATES + (size_t)2 * T_ * DM}; pg8::gemm_phase(lds, tid, DATT, DM, DATT, S, E); }
        }
        PH_END

        PH_BEGIN(7)
        const auto WO = P_WO;
        const auto ACT = P_ACT;
        const auto YB = P_YB;
        const auto xin = P_xin;
        { pg8::StdSched S; S.init(YB, DM, WO, DM, T_, DM, G, bid); EpiResid E{xin, X, ACT, P_RSS + (size_t)(2 * l) * T_}; pg8::gemm_phase(lds, tid, DM, DM, DM, S, E); }
        PH_END

        PH_BEGIN(9)
        const auto WUP = P_WUP;
        const auto ACT = P_ACT;
        const auto HID = P_HID;
        { pg8::StdSched S; S.init(ACT, DM, WUP, DM, T_, DFF, G, bid); EpiRelu2 E{HID, P_RSS + (size_t)(2 * l) * T_}; pg8::gemm_phase(lds, tid, DM, DM, DM, S, E); }
        PH_END

        PH_BEGIN(10)
        const auto WDN = P_WDN;
        const auto HID = P_HID;
        { pg8::StdSched S; S.init(HID, DFF, WDN, DFF, T_, DM, G, bid); EpiResid E{X, X, (l + 1 < NLAYER) ? (bf16_t*)P_ACT : (bf16_t*)nullptr, P_RSS + (size_t)(2 * l + 1) * T_}; pg8::gemm_phase(lds, tid, DFF, DFF, DFF, S, E); }
        PH_END
    }

    PH_BEGIN(11)
    {
        const float* fg = in_at(p, 26, 0);
        for (int m = gw; m < T_; m += NGW) { f32x4* xr = (f32x4*)(X + (size_t)m * DM) + lane; f32x4 v[8]; float s = 0.f;
#pragma unroll
            for (int j = 0; j < 8; ++j) { v[j] = xr[64 * j]; s += (v[j].x * v[j].x + v[j].y * v[j].y) + (v[j].z * v[j].z + v[j].w * v[j].w); }
            const float rstd = rsqrtf(wave_sum(s, lane) * (1.f / DM) + NORM_EPS);
#pragma unroll
            for (int j = 0; j < 8; ++j) { const f32x4 g = *((const f32x4*)fg + lane + 64 * j); xr[64 * j] = v[j] * rstd * g; }
        }
    }
    PH_END
#undef PH_BEGIN
#undef PH_END
}

constexpr int N_PHASES = NLAYER * 9 + 1;

extern "C" void kernel_launch(void* const* d_in, const int* in_sizes, int n_in, void* d_out, int out_size, void* d_ws, size_t ws_size, hipStream_t stream) {
    static int grid = 0;
    if (grid == 0) {
        if (n_in != 27 || ws_size < WS_END) { fprintf(stderr, "kernel_launch: unexpected n_in %d or ws_size %zu (need %zu)\n", n_in, ws_size, (size_t)WS_END); }
        int dev = 0, cus = 0, per_cu = 0;
        hipGetDevice(&dev); hipDeviceGetAttribute(&cus, hipDeviceAttributeMultiprocessorCount, dev);
        hipFuncSetAttribute((const void*)fwd_kernel, hipFuncAttributeMaxDynamicSharedMemorySize, LDS_BYTES);
        hipOccupancyMaxActiveBlocksPerMultiprocessor(&per_cu, (const void*)fwd_kernel, 512, LDS_BYTES);
        if (per_cu < 1) per_cu = 1;
        grid = cus * per_cu;
        (void)hipGetLastError();
    }
    Params p{};
    for (int i = 0; i < 27; ++i) p.in[i] = (const float*)d_in[i];
    p.out = (float*)d_out; p.ws = (unsigned char*)d_ws; p.ph_lo = 0; p.ph_hi = N_PHASES;
    (void)hipMemsetAsync((unsigned char*)d_ws + WS_CTL + CTL_BAR, 0, CTL_ZERO_BYTES, stream);
    void* args[] = {&p};
    hipError_t e = hipLaunchCooperativeKernel((const void*)fwd_kernel, dim3(grid), dim3(512), args, LDS_BYTES, stream);
    if (e != hipSuccess) fprintf(stderr, "cooperative launch failed: %s (grid %d)\n", hipGetErrorString(e), grid);
#ifdef PROBE_LIST
    { const int probe[] = {PROBE_LIST};
      for (unsigned i = 0; i < sizeof(probe) / sizeof(int); ++i) { p.ph_lo = probe[i]; p.ph_hi = probe[i] + 1; p.flags = PROBE_FLAGS; void* a2[] = {&p};
          hipLaunchCooperativeKernel((const void*)fwd_kernel, dim3(grid), dim3(512), a2, LDS_BYTES, stream); } }
#endif
}
```
